# Optimizing an MI355X kernel written in HIP

```python
import math
import jax
import jax.numpy as jnp
from jax import lax
import numpy as np

D_MODEL = 2048
BATCH = 32
SEQ = 256
DEPTH = 4
DEC_BATCH = 2
DEC_SEQ = 1024
PAST_LEN = 256

GRID_W = 64
ROPE_THETA = 10000.0
Q_BLOCK = 128
EPS = 1e-6
HEAD_DIM = 128
N_EVEN = (DEPTH + 1) // 2
N_ODD = DEPTH // 2

DA_HEADS = 8
DA_SUB = HEAD_DIM // 2
GQ_HEADS = 8
GQ_KV_HEADS = 2
GQ_REP = GQ_HEADS // GQ_KV_HEADS
ML_HEADS = 8
ML_DK = 128
ML_DV = 128
ML_CHUNK = 64
ML_CONV = 3
MLA_HEADS = 8
MLA_Q_RANK = 512
MLA_KV_RANK = 256
MLA_NOPE = 128
MLA_ROPE = 64
MLA_V = 128
D_FF = 5632
FFN_CONV = 3

EVEN_WIDTHS = (DA_HEADS * HEAD_DIM, DA_HEADS * HEAD_DIM, DA_HEADS * HEAD_DIM,
               GQ_HEADS * HEAD_DIM, GQ_KV_HEADS * HEAD_DIM, GQ_KV_HEADS * HEAD_DIM)
ODD_WIDTHS = (ML_HEADS * ML_DK, ML_HEADS * ML_DK, ML_HEADS * ML_DV, ML_HEADS * ML_DV,
              4 * ML_HEADS, MLA_Q_RANK, MLA_KV_RANK, MLA_ROPE)
EVEN_IN = sum(EVEN_WIDTHS)
ODD_IN = sum(ODD_WIDTHS)
EVEN_MIX = DA_HEADS * HEAD_DIM + GQ_HEADS * HEAD_DIM
ODD_MIX = ML_HEADS * ML_DV + MLA_HEADS * MLA_V

kernel_name = 'hybrid_diffusion_prefix_trunk_step'


def _split(x, widths):
    offs, acc = [], 0
    for w in widths[:-1]:
        acc += w
        offs.append(acc)
    return jnp.split(x, offs, axis=-1)


def _rms(x, g):
    xf = x.astype(jnp.float32)
    y = xf * lax.rsqrt(jnp.mean(xf * xf, axis=-1, keepdims=True) + EPS)
    return (y * g.astype(jnp.float32)).astype(x.dtype)


def _adaln(cvec, w, b):
    m = (jax.nn.silu(cvec) @ w + b)[:, None, :]
    return jnp.split(m, 6, axis=-1)


def _modulate(x, g, shift, scale):
    return _rms(x, g) * (1 + scale) + shift


def _dwconv(x, w, b):
    width = w.shape[0]
    pad = width // 2
    n = x.shape[1]
    xp = jnp.pad(x, ((0, 0), (pad, pad), (0, 0)))
    y = b
    for i in range(width):
        y = y + xp[:, i:i + n] * w[i]
    return y


def _rope_tables(grid_rows, dim):
    t = jnp.arange(grid_rows * GRID_W)
    r = (t // GRID_W).astype(jnp.float32)
    col = (t % GRID_W).astype(jnp.float32)
    quarter = dim // 4
    inv = ROPE_THETA ** (-jnp.arange(quarter, dtype=jnp.float32) / quarter)
    ang = jnp.stack([r[:, None] * inv, col[:, None] * inv], axis=1)
    return jnp.cos(ang), jnp.sin(ang)


def _rope(x, cos, sin):
    quarter = x.shape[-1] // 4
    xr = x.astype(jnp.float32).reshape(x.shape[:-1] + (2, 2, quarter))
    x1, x2 = xr[..., 0, :], xr[..., 1, :]
    out = jnp.stack([x1 * cos - x2 * sin, x1 * sin + x2 * cos], axis=-2)
    return out.reshape(x.shape).astype(x.dtype)


def _over_query_blocks(fn, queries):
    n_q = queries[0].shape[-2]
    nb = n_q // Q_BLOCK

    def split(a):
        a = a.reshape(a.shape[:-2] + (nb, Q_BLOCK, a.shape[-1]))
        return jnp.moveaxis(a, -3, 0)

    out = lax.map(lambda blk: fn(*blk), tuple(split(a) for a in queries))
    out = jnp.moveaxis(out, 0, -3)
    return out.reshape(out.shape[:-3] + (n_q, out.shape[-1]))


def _diff_attention(q, k, v, lam, ln_g, lam_init):
    scale = DA_SUB ** -0.5

    def block(qb):
        s = jnp.einsum('bhcqd,bhckd->bhcqk', qb, k, preferred_element_type=jnp.float32) * scale
        a = jax.nn.softmax(s, axis=-1)
        w = a[:, :, 0] - lam * a[:, :, 1]
        return jnp.einsum('bhqk,bhkd->bhqd', w.astype(v.dtype), v)

    o = _over_query_blocks(block, (q,))
    return _rms(o, ln_g) * (1.0 - lam_init)


def _gqa(q, k, v):
    scale = HEAD_DIM ** -0.5

    def block(qb):
        s = jnp.einsum('bgrqd,bgkd->bgrqk', qb, k, preferred_element_type=jnp.float32) * scale
        a = jax.nn.softmax(s, axis=-1)
        return jnp.einsum('bgrqk,bgkd->bgrqd', a.astype(v.dtype), v)

    return _over_query_blocks(block, (q,))


def _mla_attention(q_nope, q_pe, k_nope, k_pe, v):
    scale = (MLA_NOPE + MLA_ROPE) ** -0.5

    def block(qn, qp):
        s = (jnp.einsum('bhqd,bhkd->bhqk', qn, k_nope, preferred_element_type=jnp.float32)
             + jnp.einsum('bhqd,bkd->bhqk', qp, k_pe, preferred_element_type=jnp.float32)) * scale
        a = jax.nn.softmax(s, axis=-1)
        return jnp.einsum('bhqk,bhkd->bhqd', a.astype(v.dtype), v)

    return _over_query_blocks(block, (q_nope, q_pe))


def _mla_kv(ckv, w_ukv):
    b_, s_, _ = ckv.shape
    kv = (ckv @ w_ukv).reshape(b_, s_, MLA_HEADS, MLA_NOPE + MLA_V).transpose(0, 2, 1, 3)
    return kv[..., :MLA_NOPE], kv[..., MLA_NOPE:]


def _mlstm_scan(q, k, v, log_i, log_f, c0, n0, m0):
    b_, h_, n_tok, _ = q.shape
    nc = n_tok // ML_CHUNK
    f32 = jnp.float32

    def chunks(a):
        a = a.astype(f32)
        a = a.reshape(a.shape[:2] + (nc, ML_CHUNK) + a.shape[3:])
        return jnp.moveaxis(a, 2, 0)

    tril = jnp.tril(jnp.ones((ML_CHUNK, ML_CHUNK), dtype=bool))

    def step(carry, inp):
        cst, nst, mst = carry
        qc, kc, vc, li, lf = inp
        bcum = jnp.cumsum(lf, axis=-1)
        d_intra = jnp.where(tril, bcum[..., :, None] - bcum[..., None, :] + li[..., None, :], -jnp.inf)
        d_inter = bcum + mst[..., None]
        m_t = jnp.maximum(d_inter, jnp.max(d_intra, axis=-1))
        s = jnp.einsum('bhtd,bhsd->bhts', qc, kc) * jnp.exp(d_intra - m_t[..., None])
        a = jnp.exp(d_inter - m_t)
        num = jnp.einsum('bhts,bhsv->bhtv', s, vc) + a[..., None] * jnp.einsum('bhtd,bhdv->bhtv', qc, cst)
        den = jnp.sum(s, axis=-1) + a * jnp.einsum('bhtd,bhd->bht', qc, nst)
        h = num / jnp.maximum(jnp.abs(den), jnp.exp(-m_t))[..., None]
        b_end = bcum[..., -1]
        g = b_end[..., None] - bcum + li
        m_new = jnp.maximum(b_end + mst, jnp.max(g, axis=-1))
        wg = jnp.exp(g - m_new[..., None])
        decay = jnp.exp(b_end + mst - m_new)
        c_new = decay[..., None, None] * cst + jnp.einsum('bhs,bhsd,bhsv->bhdv', wg, kc, vc)
        n_new = decay[..., None] * nst + jnp.einsum('bhs,bhsd->bhd', wg, kc)
        return (c_new, n_new, m_new), h

    init = (c0.astype(f32), n0.astype(f32), m0.astype(f32))
    (c_fin, n_fin, m_fin), hs = lax.scan(step, init, (chunks(q), chunks(k), chunks(v), chunks(log_i), chunks(log_f)))
    h = jnp.moveaxis(hs, 0, 2).reshape(b_, h_, n_tok, hs.shape[-1])
    return h, c_fin, n_fin, m_fin


def _mlstm_mixer(qm, km, vm, om, gates, gate_b, norm_g, c0, n0, m0):
    b_, h_, n_tok, _ = qm.shape
    g = (gates + gate_b).astype(jnp.float32).reshape(b_, n_tok, 4, ML_HEADS).transpose(2, 0, 3, 1)
    i_f, lf_f = g[0], jax.nn.log_sigmoid(g[1])
    i_b, lf_b = g[2], jax.nn.log_sigmoid(g[3])
    h_f, c_f, n_f, m_f = _mlstm_scan(qm, km, vm, i_f, lf_f, c0[:, 0], n0[:, 0], m0[:, 0])

    def rev(a):
        return jnp.flip(a, axis=2)

    h_b, c_b, n_b, m_b = _mlstm_scan(rev(qm), rev(km), rev(vm), rev(i_b), rev(lf_b), c0[:, 1], n0[:, 1], m0[:, 1])
    h = _rms(h_f + rev(h_b), norm_g)
    h = h.transpose(0, 2, 1, 3).reshape(b_, n_tok, h_ * ML_DV).astype(om.dtype) * jax.nn.sigmoid(om)
    return h, (jnp.stack([c_f, c_b], axis=1), jnp.stack([n_f, n_b], axis=1), jnp.stack([m_f, m_b], axis=1))


def _even_heads(h, w_in, q_norm_g, k_norm_g):
    b_, n_tok, _ = h.shape
    qa, ka, va, qb, kb, vb = _split(h @ w_in, EVEN_WIDTHS)

    def sub(a):
        return a.reshape(b_, n_tok, DA_HEADS, 2, DA_SUB).transpose(0, 2, 3, 1, 4)

    qa, ka = sub(qa), sub(ka)
    va = va.reshape(b_, n_tok, DA_HEADS, HEAD_DIM).transpose(0, 2, 1, 3)
    qb = _rms(qb.reshape(b_, n_tok, GQ_KV_HEADS, GQ_REP, HEAD_DIM), q_norm_g).transpose(0, 2, 3, 1, 4)
    kb = _rms(kb.reshape(b_, n_tok, GQ_KV_HEADS, HEAD_DIM), k_norm_g).transpose(0, 2, 1, 3)
    vb = vb.reshape(b_, n_tok, GQ_KV_HEADS, HEAD_DIM).transpose(0, 2, 1, 3)
    return qa, ka, va, qb, kb, vb


def _even_merge(oa, ob, w_out):
    b_, _, n_tok, _ = oa.shape
    oa = oa.transpose(0, 2, 1, 3).reshape(b_, n_tok, DA_HEADS * HEAD_DIM)
    ob = ob.transpose(0, 3, 1, 2, 4).reshape(b_, n_tok, GQ_HEADS * HEAD_DIM)
    return jnp.concatenate([oa, ob], axis=-1) @ w_out


def _odd_heads(h, w_in, conv_w, conv_b, q_norm_g, w_uq, kv_norm_g):
    b_, n_tok, _ = h.shape
    qm, km, vm, om, gates, q_down, kv_down, k_pe = _split(h @ w_in, ODD_WIDTHS)
    qk = jax.nn.silu(_dwconv(jnp.concatenate([qm, km], axis=-1), conv_w, conv_b))
    qm, km = jnp.split(qk, 2, axis=-1)

    def heads(a, d):
        return a.reshape(b_, n_tok, ML_HEADS, d).transpose(0, 2, 1, 3)

    qm = heads(qm, ML_DK) * (ML_DK ** -0.5)
    km = heads(km, ML_DK)
    vm = heads(vm, ML_DV)
    cq = (_rms(q_down, q_norm_g) @ w_uq).reshape(b_, n_tok, MLA_HEADS, MLA_NOPE + MLA_ROPE).transpose(0, 2, 1, 3)
    ckv = _rms(kv_down, kv_norm_g)
    return qm, km, vm, om, gates, cq[..., :MLA_NOPE], cq[..., MLA_NOPE:], ckv, k_pe


def _odd_merge(h_ml, h_mla, w_out):
    b_, _, n_tok, _ = h_mla.shape
    h_mla = h_mla.transpose(0, 2, 1, 3).reshape(b_, n_tok, MLA_HEADS * MLA_V)
    return jnp.concatenate([h_ml, h_mla], axis=-1) @ w_out


def _conv_ffn(h, w_up, conv_w, conv_b, w_down):
    u = _dwconv(h @ w_up, conv_w, conv_b)
    g, up = jnp.split(u, 2, axis=-1)
    return (jax.nn.silu(g) * up) @ w_down


def setup_inputs(seed: int = 0) -> dict:
    key = jax.random.key(seed)
    keys = iter(jax.random.split(key, 64))

    def nrm(shape, scale=1.0):
        return scale * jax.random.normal(next(keys), shape, dtype=jnp.float32)

    def gain(shape):
        return 1.0 + 0.05 * nrm(shape)

    D = D_MODEL
    f_bias = jnp.linspace(3.0, 6.0, ML_HEADS, dtype=jnp.float32)
    i_bias = jnp.zeros((ML_HEADS,), jnp.float32)
    gate_base = jnp.concatenate([i_bias, f_bias, i_bias, f_bias])
    return dict(
        x_prompt=nrm((BATCH, SEQ, D)),
        x_sample=nrm((DEC_BATCH, DEC_SEQ, D)),
        cache_da_k=nrm((DEC_BATCH, N_EVEN, DA_HEADS, 2, PAST_LEN, DA_SUB)),
        cache_da_v=nrm((DEC_BATCH, N_EVEN, DA_HEADS, PAST_LEN, HEAD_DIM)),
        cache_gq_k=nrm((DEC_BATCH, N_EVEN, GQ_KV_HEADS, PAST_LEN, HEAD_DIM)),
        cache_gq_v=nrm((DEC_BATCH, N_EVEN, GQ_KV_HEADS, PAST_LEN, HEAD_DIM)),
        cache_mla_ckv=nrm((DEC_BATCH, N_ODD, PAST_LEN, MLA_KV_RANK)),
        cache_mla_kpe=nrm((DEC_BATCH, N_ODD, PAST_LEN, MLA_ROPE)),
        state_ml_C=nrm((DEC_BATCH, N_ODD, 2, ML_HEADS, ML_DK, ML_DV)),
        state_ml_n=nrm((DEC_BATCH, N_ODD, 2, ML_HEADS, ML_DK)),
        state_ml_m=nrm((DEC_BATCH, N_ODD, 2, ML_HEADS)),
        c=nrm((DEC_BATCH, D)),
        c_ctx=nrm((D,)),
        norm1_g=gain((DEPTH, D)),
        norm2_g=gain((DEPTH, D)),
        w_mod=nrm((DEPTH, D, 6 * D), 0.5 * D ** -0.5),
        b_mod=nrm((DEPTH, 6 * D), 0.02),
        even_w_in=nrm((N_EVEN, D, EVEN_IN), D ** -0.5),
        even_w_out=nrm((N_EVEN, EVEN_MIX, D), EVEN_MIX ** -0.5),
        da_lambda=nrm((N_EVEN, 4, DA_SUB), 0.1),
        da_subln_g=gain((N_EVEN, HEAD_DIM)),
        gq_q_norm_g=gain((N_EVEN, HEAD_DIM)),
        gq_k_norm_g=gain((N_EVEN, HEAD_DIM)),
        odd_w_in=nrm((N_ODD, D, ODD_IN), D ** -0.5),
        odd_w_out=nrm((N_ODD, ODD_MIX, D), ODD_MIX ** -0.5),
        ml_conv_w=nrm((N_ODD, ML_CONV, 2 * ML_HEADS * ML_DK), ML_CONV ** -0.5),
        ml_conv_b=nrm((N_ODD, 2 * ML_HEADS * ML_DK), 0.02),
        ml_gate_b=gate_base[None, :] + nrm((N_ODD, 4 * ML_HEADS), 0.1),
        ml_norm_g=gain((N_ODD, ML_DV)),
        mla_q_norm_g=gain((N_ODD, MLA_Q_RANK)),
        mla_w_uq=nrm((N_ODD, MLA_Q_RANK, MLA_HEADS * (MLA_NOPE + MLA_ROPE)), MLA_Q_RANK ** -0.5),
        mla_kv_norm_g=gain((N_ODD, MLA_KV_RANK)),
        mla_w_ukv=nrm((N_ODD, MLA_KV_RANK, MLA_HEADS * (MLA_NOPE + MLA_V)), MLA_KV_RANK ** -0.5),
        ffn_w_up=nrm((DEPTH, D, 2 * D_FF), D ** -0.5),
        ffn_conv_w=nrm((DEPTH, FFN_CONV, 2 * D_FF), FFN_CONV ** -0.5),
        ffn_conv_b=nrm((DEPTH, 2 * D_FF), 0.02),
        ffn_w_down=nrm((DEPTH, D_FF, D), D_FF ** -0.5),
        final_norm_g=gain((D,)),
    )


def reference(x_prompt, x_sample, cache_da_k, cache_da_v, cache_gq_k, cache_gq_v,
              cache_mla_ckv, cache_mla_kpe, state_ml_C, state_ml_n, state_ml_m,
              c, c_ctx, norm1_g, norm2_g, w_mod, b_mod, even_w_in, even_w_out,
              da_lambda, da_subln_g, gq_q_norm_g, gq_k_norm_g, odd_w_in, odd_w_out,
              ml_conv_w, ml_conv_b, ml_gate_b, ml_norm_g, mla_q_norm_g, mla_w_uq,
              mla_kv_norm_g, mla_w_ukv, ffn_w_up, ffn_conv_w, ffn_conv_b, ffn_w_down,
              final_norm_g):
    grid_rows = x_sample.shape[1] // GRID_W
    cos_sub, sin_sub = _rope_tables(grid_rows, DA_SUB)
    cos_hd, sin_hd = _rope_tables(grid_rows, HEAD_DIM)
    cos_pe, sin_pe = _rope_tables(grid_rows, MLA_ROPE)
    b_ctx = x_prompt.shape[0]
    cond_ctx = c_ctx[None, :]
    xp, xs = x_prompt, x_sample
    da_k_l, da_v_l, gq_k_l, gq_v_l = [], [], [], []
    ckv_l, kpe_l, mC_l, mn_l, mm_l = [], [], [], [], []
    for l in range(DEPTH):
        mod_p = _adaln(cond_ctx, w_mod[l], b_mod[l])
        mod_s = _adaln(c, w_mod[l], b_mod[l])
        hp = _modulate(xp, norm1_g[l], mod_p[0], mod_p[1])
        hs = _modulate(xs, norm1_g[l], mod_s[0], mod_s[1])
        j = l // 2
        if l % 2 == 0:
            lam_init = 0.8 - 0.6 * math.exp(-0.3 * l)
            lq1, lk1, lq2, lk2 = da_lambda[j].astype(jnp.float32)
            lam = jnp.exp(jnp.sum(lq1 * lk1)) - jnp.exp(jnp.sum(lq2 * lk2)) + lam_init
            qa, ka, va, qb, kb, vb = _even_heads(hp, even_w_in[j], gq_q_norm_g[j], gq_k_norm_g[j])
            out_p = _even_merge(_diff_attention(qa, ka, va, lam, da_subln_g[j], lam_init),
                                _gqa(qb, kb, vb), even_w_out[j])
            da_k_l.append(ka)
            da_v_l.append(va)
            gq_k_l.append(kb)
            gq_v_l.append(vb)
            qa, ka, va, qb, kb, vb = _even_heads(hs, even_w_in[j], gq_q_norm_g[j], gq_k_norm_g[j])
            ka = jnp.concatenate([cache_da_k[:, j], _rope(ka, cos_sub, sin_sub)], axis=3)
            va = jnp.concatenate([cache_da_v[:, j], va], axis=2)
            kb = jnp.concatenate([cache_gq_k[:, j], _rope(kb, cos_hd, sin_hd)], axis=2)
            vb = jnp.concatenate([cache_gq_v[:, j], vb], axis=2)
            out_s = _even_merge(_diff_attention(_rope(qa, cos_sub, sin_sub), ka, va, lam, da_subln_g[j], lam_init),
                                _gqa(_rope(qb, cos_hd, sin_hd), kb, vb), even_w_out[j])
        else:
            qm, km, vm, om, gates, q_nope, q_pe, ckv, k_pe = _odd_heads(
                hp, odd_w_in[j], ml_conv_w[j], ml_conv_b[j], mla_q_norm_g[j], mla_w_uq[j], mla_kv_norm_g[j])
            zc = jnp.zeros((b_ctx, 2, ML_HEADS, ML_DK, ML_DV), jnp.float32)
            zn = jnp.zeros((b_ctx, 2, ML_HEADS, ML_DK), jnp.float32)
            zm = jnp.zeros((b_ctx, 2, ML_HEADS), jnp.float32)
            h_ml, (st_c, st_n, st_m) = _mlstm_mixer(qm, km, vm, om, gates, ml_gate_b[j], ml_norm_g[j], zc, zn, zm)
            k_nope, v = _mla_kv(ckv, mla_w_ukv[j])
            out_p = _odd_merge(h_ml, _mla_attention(q_nope, q_pe, k_nope, k_pe, v), odd_w_out[j])
            ckv_l.append(ckv)
            kpe_l.append(k_pe)
            mC_l.append(st_c)
            mn_l.append(st_n)
            mm_l.append(st_m)
            qm, km, vm, om, gates, q_nope, q_pe, ckv, k_pe = _odd_heads(
                hs, odd_w_in[j], ml_conv_w[j], ml_conv_b[j], mla_q_norm_g[j], mla_w_uq[j], mla_kv_norm_g[j])
            h_ml = _mlstm_mixer(qm, km, vm, om, gates, ml_gate_b[j], ml_norm_g[j],
                                state_ml_C[:, j], state_ml_n[:, j], state_ml_m[:, j])[0]
            ckv_all = jnp.concatenate([cache_mla_ckv[:, j], ckv], axis=1)
            kpe_all = jnp.concatenate([cache_mla_kpe[:, j], _rope(k_pe, cos_pe, sin_pe)], axis=1)
            k_nope, v = _mla_kv(ckv_all, mla_w_ukv[j])
            out_s = _odd_merge(h_ml, _mla_attention(q_nope, _rope(q_pe, cos_pe, sin_pe), k_nope, kpe_all, v),
                               odd_w_out[j])
        xp = xp + mod_p[2] * out_p
        xs = xs + mod_s[2] * out_s
        hp = _modulate(xp, norm2_g[l], mod_p[3], mod_p[4])
        hs = _modulate(xs, norm2_g[l], mod_s[3], mod_s[4])
        xp = xp + mod_p[5] * _conv_ffn(hp, ffn_w_up[l], ffn_conv_w[l], ffn_conv_b[l], ffn_w_down[l])
        xs = xs + mod_s[5] * _conv_ffn(hs, ffn_w_up[l], ffn_conv_w[l], ffn_conv_b[l], ffn_w_down[l])
    y_prompt = _rms(xp, final_norm_g)
    y_sample = _rms(xs, final_norm_g)
    new_da_k = jnp.stack(da_k_l, axis=1)
    new_da_v = jnp.stack(da_v_l, axis=1)
    new_gq_k = jnp.stack(gq_k_l, axis=1)
    new_gq_v = jnp.stack(gq_v_l, axis=1)
    new_mla_ckv = jnp.stack(ckv_l, axis=1)
    new_mla_kpe = jnp.stack(kpe_l, axis=1)
    new_ml_C = jnp.stack(mC_l, axis=1)
    new_ml_n = jnp.stack(mn_l, axis=1)
    new_ml_m = jnp.stack(mm_l, axis=1)
    return (y_prompt, y_sample, new_da_k, new_da_v, new_gq_k, new_gq_v, new_mla_ckv, new_mla_kpe, new_ml_C, new_ml_n, new_ml_m)
```

```cpp
#include <hip/hip_runtime.h>
#include <cstdio>
#include <cstdint>

namespace pg8 {
#define PG8_LAS __attribute__((address_space(3)))
typedef unsigned short bf16_t;
typedef short bf16x8 __attribute__((ext_vector_type(8)));
typedef float f32x4 __attribute__((ext_vector_type(4)));
typedef unsigned u32x4 __attribute__((ext_vector_type(4)));
constexpr int BM = 256, BK = 64, HALF = 128, HTB = HALF * BK * 2  , STAGE_BYTES = 8 * HTB, NXCD = 8, WGM = 8;

__host__ __device__ __forceinline__ int lds_byte(int r, int c) { const int st = (r >> 4) * 2 + (c >> 5), rr = r & 15, cc = c & 31, ob = rr * 64 + cc * 2; return st * 1024 + (ob ^ (((ob >> 9) & 1) << 5)); }
__host__ __device__ __forceinline__ void stage_rc(int b, int& R, int& C) { const int st = b / 1024, sb = b % 1024, swz = sb ^ (((sb >> 9) & 1) << 5); R = (st >> 1) * 16 + swz / 64; C = (st & 1) * 32 + (swz % 64) / 2; }
__host__ __device__ __forceinline__ int perm32(int rho) { const int n = rho >> 4, i = rho & 15; return 8 * (i >> 2) + 4 * n + (i & 3); }

struct Unit { int pm, pn, koff, ks; };
struct Gemm { const bf16_t* A; const bf16_t* Bt; int M, N, K, ld; };

struct StaticOrder {
    int nM, nN, nwg, G, c;
    __host__ __device__ void init(int M, int N, int G_, int c_) { nM = M / BM; nN = N / BM; nwg = nM * nN; G = G_; c = c_; }
    __host__ __device__ bool next(int i, Unit& u) const {
        const long L = (long)i * G + c; if (L >= nwg) return false;
        int wgid = (int)L; { const int q = nwg / NXCD, r = nwg % NXCD, xcd = wgid % NXCD, off = wgid / NXCD; wgid = (xcd < r ? xcd * (q + 1) : r * (q + 1) + (xcd - r) * q) + off; }
        const int nig = WGM * nN, gid = wgid / nig, fm = gid * WGM, gsz = (nM - fm) < WGM ? (nM - fm) : WGM;
        u.pm = fm + ((wgid % nig) % gsz); u.pn = (wgid % nig) / gsz; u.koff = 0; u.ks = 0; return true;
    }
    __device__ __forceinline__ void a_ready(const Unit&) const {}
    __device__ __forceinline__ void done(const Unit&) const {}
    __device__ __forceinline__ int unit_nt(const Unit&, int nt_gemm) const { return nt_gemm; }
};

__device__ __forceinline__ unsigned cvt_pk_bf16(float lo, float hi) { unsigned r; asm volatile("v_cvt_pk_bf16_f32 %0, %1, %2" : "=v"(r) : "v"(lo), "v"(hi)); return r; }
typedef float f32x2 __attribute__((ext_vector_type(2)));
__device__ __forceinline__ f32x2 gelu_pk(f32x2 v) {
    const f32x2 av = __builtin_elementwise_abs(v), d = av * 0.2316418882f + 1.0f;
    f32x2 t; t.x = __builtin_amdgcn_rcpf(d.x); t.y = __builtin_amdgcn_rcpf(d.y);
    f32x2 q = t * 0.5307027145f + (-0.7265760135f); q = q * t + 0.7107068705f; q = q * t + (-0.142248368f); q = q * t + 0.127414796f; q = q * t;
    const f32x2 s = (v * v) * (-0.72134752044f);
    f32x2 e; e.x = __builtin_amdgcn_exp2f(s.x); e.y = __builtin_amdgcn_exp2f(s.y);
    const f32x2 m = v * (q * e), r = v - m;
    f32x2 o; o.x = v.x < 0.f ? m.x : r.x; o.y = v.y < 0.f ? m.y : r.y; return o;
}

template <int ACT  > struct EpiBf16 {
    static constexpr bool PERM = true, AFTER_DRAIN = false, ROWPERM = false; static_assert(ACT == 0 || ACT == 1, "EpiBf16: ACT is 0 (none) or 1 (gelu_pk)");
    bf16_t* O; int ldc; const float* bias; int split_cols; size_t split_stride; float scale0;
    __device__ __forceinline__ void operator()(const f32x4 (&acc)[2][2][4][2], const Unit& u, int wr, int wc, int fr, int fq) const {
        const int row0 = u.pm * BM + wr * 64 + fr; int colt = u.pn * BM; bf16_t* base = O;
        float sc = 1.f; if (split_cols) { const int t = colt / split_cols; base += (size_t)t * split_stride; colt -= t * split_cols; if (t == 0) sc = scale0; }
        const int col0 = colt + wc * 32 + 8 * fq, bcol0 = u.pn * BM + wc * 32 + 8 * fq;
        f32x4 bv[2][2];
#pragma unroll
        for (int bj = 0; bj < 2; ++bj)
#pragma unroll
            for (int n = 0; n < 2; ++n) bv[bj][n] = bias ? *(const f32x4*)(bias + bcol0 + bj * HALF + 4 * n) : (f32x4){0.f, 0.f, 0.f, 0.f};
#pragma unroll
        for (int ai = 0; ai < 2; ++ai)
#pragma unroll
            for (int m = 0; m < 4; ++m) { bf16_t* rowp = base + (size_t)(row0 + ai * HALF + m * 16) * ldc + col0;
#pragma unroll
                for (int bj = 0; bj < 2; ++bj) { f32x4 v0 = acc[ai][bj][m][0] + bv[bj][0], v1 = acc[ai][bj][m][1] + bv[bj][1];
                    if (ACT == 1) { f32x2 a = gelu_pk((f32x2){v0[0], v0[1]}), b = gelu_pk((f32x2){v0[2], v0[3]}), c = gelu_pk((f32x2){v1[0], v1[1]}), d = gelu_pk((f32x2){v1[2], v1[3]});
                        v0 = (f32x4){a.x, a.y, b.x, b.y}; v1 = (f32x4){c.x, c.y, d.x, d.y}; }
                    v0 = v0 * sc; v1 = v1 * sc; u32x4 w; w.x = cvt_pk_bf16(v0[0], v0[1]); w.y = cvt_pk_bf16(v0[2], v0[3]); w.z = cvt_pk_bf16(v1[0], v1[1]); w.w = cvt_pk_bf16(v1[2], v1[3]);
                    *(u32x4*)(rowp + bj * HALF) = w; } }
    }
};

template <class Epi, class Sched, bool ALIGN_EPI = false, bool SP2 = false>
__device__ __forceinline__ void gemm_phase(PG8_LAS unsigned char* lds, const Gemm g, const Sched& S, const Epi& E, const int tid) {
    const int wid = __builtin_amdgcn_readfirstlane(tid >> 6), lane = tid & 63, wr = wid >> 2, wc = wid & 3, fr = lane & 15, fq = lane >> 4;
    const int K = g.ld;
    unsigned voffA[2], voffB[2];
#pragma unroll
    for (int i = 0; i < 2; ++i) { int R, C; stage_rc(tid * 16 + i * 8192, R, C); const int Rb = Epi::PERM ? ((R & ~31) + perm32(R & 31)) : R;
        const int Ra = Epi::ROWPERM ? (8 * (16 * (R >> 6) + (R & 15)) + ((R >> 4) & 3)) : R;
        voffA[i] = (unsigned)(Ra * K + C) * 2u; voffB[i] = (unsigned)(Rb * K + C) * 2u; }
    const size_t kstep = (size_t)(BK * 2);
    const size_t hstep = (size_t)HALF * K * 2;
    const size_t tstep = 2 * hstep;
    const size_t hstepA = Epi::ROWPERM ? (size_t)4 * K * 2 : hstep;
    const unsigned ldsw = (unsigned)wid * 1024u;
    const int aoff = lds_byte(wr * 64 + fr, fq * 8), boff = lds_byte(wc * 32 + fr, fq * 8);
#define PG8_SA(b, h) (((b) * 2 + (h)) * HTB)
#define PG8_SB(b, h) ((4 + (b) * 2 + (h)) * HTB)
#define PG8_STAGE(bufoff, gbase, voff) do { _Pragma("unroll") for (int _i = 0; _i < 2; ++_i) \
        __builtin_amdgcn_global_load_lds((const unsigned*)((const char*)(gbase) + (voff)[_i]), (PG8_LAS unsigned*)(lds + (bufoff) + ldsw + _i * 8192), 16, 0, 0); } while (0)
#define PG8_LDA(dst, b, h) do { _Pragma("unroll") for (int m = 0; m < 4; ++m) _Pragma("unroll") for (int k = 0; k < 2; ++k) dst[m][k] = *(const PG8_LAS bf16x8*)(lds + PG8_SA(b, h) + aoff + m * 2048 + k * 1024); } while (0)
#define PG8_LDB(dst, b, h) do { _Pragma("unroll") for (int n = 0; n < 2; ++n) _Pragma("unroll") for (int k = 0; k < 2; ++k) dst[n][k] = *(const PG8_LAS bf16x8*)(lds + PG8_SB(b, h) + boff + n * 2048 + k * 1024); } while (0)
#define PG8_MMA(ai, bj, At, Bt) do { __builtin_amdgcn_s_setprio(1); _Pragma("unroll") for (int m = 0; m < 4; ++m) _Pragma("unroll") for (int n = 0; n < 2; ++n) _Pragma("unroll") for (int k = 0; k < 2; ++k) \
        acc[ai][bj][m][n] = __builtin_amdgcn_mfma_f32_16x16x32_bf16(Bt[n][k], At[m][k], acc[ai][bj][m][n], 0, 0, 0); __builtin_amdgcn_s_setprio(0); } while (0)
#define PG8_WAIT_V(n) asm volatile("s_waitcnt vmcnt(" #n ")" ::: "memory")
#define PG8_WAIT_L(n) asm volatile("s_waitcnt lgkmcnt(" #n ")" ::: "memory")
#define PG8_BAR __builtin_amdgcn_s_barrier()
#define PG8_SCHED __builtin_amdgcn_sched_barrier(0)
    Unit cur, nxt; int ui = 0;
    if (!S.next(0, cur)) return;
    int nt = S.unit_nt(cur, g.K / BK);
    f32x4 acc[2][2][4][2];
#pragma unroll
    for (int a = 0; a < 2; ++a)
#pragma unroll
        for (int b = 0; b < 2; ++b)
#pragma unroll
            for (int m = 0; m < 4; ++m)
#pragma unroll
                for (int n = 0; n < 2; ++n) acc[a][b][m][n] = (f32x4){0.f, 0.f, 0.f, 0.f};
    bf16x8 At[4][2], B0[2][2], B1[2][2];
    const char* cA = (const char*)g.A + (size_t)cur.pm * tstep + (size_t)cur.koff * 2; const char* cB = (const char*)g.Bt + (size_t)cur.pn * tstep + (size_t)cur.koff * 2;
    S.a_ready(cur);
    if constexpr (SP2) {
        PG8_STAGE(PG8_SB(0, 0), cB, voffB); PG8_STAGE(PG8_SB(0, 1), cB + hstep, voffB); PG8_STAGE(PG8_SA(0, 0), cA, voffA); PG8_STAGE(PG8_SA(0, 1), cA + hstepA, voffA);
        if (wr == 1) PG8_BAR;
        PG8_WAIT_V(2); PG8_BAR;
        PG8_STAGE(PG8_SB(1, 0), cB + kstep, voffB); PG8_STAGE(PG8_SA(1, 0), cA + kstep, voffA); PG8_STAGE(PG8_SB(1, 1), cB + hstep + kstep, voffB);
        PG8_WAIT_V(6); PG8_BAR;
    } else {
        PG8_STAGE(PG8_SB(0, 0), cB, voffB); PG8_STAGE(PG8_SA(0, 0), cA, voffA); PG8_STAGE(PG8_SB(0, 1), cB + hstep, voffB); PG8_STAGE(PG8_SA(0, 1), cA + hstepA, voffA);
        if (wr == 1) PG8_BAR;
        PG8_WAIT_V(4); PG8_BAR;
        PG8_STAGE(PG8_SB(1, 0), cB + kstep, voffB); PG8_STAGE(PG8_SA(1, 0), cA + kstep, voffA); PG8_STAGE(PG8_SB(1, 1), cB + hstep + kstep, voffB);
        PG8_WAIT_V(6); PG8_BAR;
    }
    for (;;) {
        const bool has_next = S.next(ui + 1, nxt);
        const char* nA = has_next ? (const char*)g.A + (size_t)nxt.pm * tstep + (size_t)nxt.koff * 2 : cA; const char* nB = has_next ? (const char*)g.Bt + (size_t)nxt.pn * tstep + (size_t)nxt.koff * 2 : cB;
        for (int t = 0; t < nt; t += 2) {
            const bool last = (t == nt - 2);
            const char* a1 = cA + (size_t)(t + 1) * kstep;
            const char* a2 = last ? nA : cA + (size_t)(t + 2) * kstep; const char* b2 = last ? nB : cB + (size_t)(t + 2) * kstep;
            const char* a3 = a2 + kstep; const char* b3 = b2 + kstep;
            if (last && has_next) S.a_ready(nxt);
            if constexpr (SP2) {
            PG8_LDB(B0, 0, 0); PG8_LDB(B1, 0, 1); PG8_SCHED; PG8_LDA(At, 0, 0); PG8_STAGE(PG8_SA(1, 1), a1 + hstepA, voffA);
            PG8_WAIT_V(8); PG8_WAIT_L(0); PG8_BAR; PG8_MMA(0, 0, At, B0); PG8_MMA(0, 1, At, B1); PG8_BAR; PG8_SCHED;
            PG8_LDA(At, 0, 1); PG8_STAGE(PG8_SB(0, 0), b2, voffB); PG8_STAGE(PG8_SB(0, 1), b2 + hstep, voffB); PG8_STAGE(PG8_SA(0, 0), a2, voffA);
            PG8_WAIT_V(8); PG8_WAIT_L(0); PG8_BAR; PG8_MMA(1, 0, At, B0); PG8_MMA(1, 1, At, B1); PG8_BAR; PG8_SCHED;
            PG8_LDB(B0, 1, 0); PG8_LDB(B1, 1, 1); PG8_SCHED; PG8_LDA(At, 1, 0); PG8_STAGE(PG8_SA(0, 1), a2 + hstepA, voffA);
            PG8_WAIT_V(8); PG8_WAIT_L(0); PG8_BAR; PG8_MMA(0, 0, At, B0); PG8_MMA(0, 1, At, B1); PG8_BAR; PG8_SCHED;
            PG8_LDA(At, 1, 1); PG8_STAGE(PG8_SB(1, 0), b3, voffB); PG8_STAGE(PG8_SB(1, 1), b3 + hstep, voffB); PG8_STAGE(PG8_SA(1, 0), a3, voffA);
            PG8_WAIT_V(8); PG8_WAIT_L(0); PG8_BAR; PG8_MMA(1, 0, At, B0); PG8_MMA(1, 1, At, B1); PG8_BAR; PG8_SCHED;
            } else {
            PG8_LDB(B0, 0, 0); PG8_SCHED; PG8_LDA(At, 0, 0); PG8_STAGE(PG8_SA(1, 1), a1 + hstepA, voffA);
            PG8_WAIT_L(8); PG8_BAR; PG8_WAIT_L(0); PG8_MMA(0, 0, At, B0); PG8_BAR; PG8_SCHED;
            PG8_LDB(B1, 0, 1); PG8_STAGE(PG8_SB(0, 0), b2, voffB);
            PG8_BAR; PG8_WAIT_L(0); PG8_MMA(0, 1, At, B1); PG8_BAR;
            PG8_LDA(At, 0, 1); PG8_STAGE(PG8_SA(0, 0), a2, voffA);
            PG8_BAR; PG8_WAIT_L(0); PG8_MMA(1, 0, At, B0); PG8_BAR; PG8_SCHED;
            PG8_STAGE(PG8_SB(0, 1), b2 + hstep, voffB);
            PG8_WAIT_V(6); PG8_BAR; PG8_MMA(1, 1, At, B1); PG8_BAR;
            PG8_LDB(B0, 1, 0); PG8_SCHED; PG8_LDA(At, 1, 0); PG8_STAGE(PG8_SA(0, 1), a2 + hstepA, voffA);
            PG8_WAIT_L(8); PG8_BAR; PG8_WAIT_L(0); PG8_MMA(0, 0, At, B0); PG8_BAR; PG8_SCHED;
            PG8_LDB(B1, 1, 1); PG8_STAGE(PG8_SB(1, 0), b3, voffB);
            PG8_BAR; PG8_WAIT_L(0); PG8_MMA(0, 1, At, B1); PG8_BAR;
            PG8_LDA(At, 1, 1); PG8_STAGE(PG8_SA(1, 0), a3, voffA);
            PG8_BAR; PG8_WAIT_L(0); PG8_MMA(1, 0, At, B0); PG8_BAR; PG8_SCHED;
            PG8_STAGE(PG8_SB(1, 1), b3 + hstep, voffB);
            PG8_WAIT_V(6); PG8_BAR; PG8_MMA(1, 1, At, B1); PG8_BAR;
            }
        }
        if constexpr (ALIGN_EPI) { if (wr == 0) PG8_BAR; }
        if constexpr (!Epi::AFTER_DRAIN) { E(acc, cur, wr, wc, fr, fq); S.done(cur); }
        if (!has_next) break;
#pragma unroll
        for (int a = 0; a < 2; ++a)
#pragma unroll
            for (int b = 0; b < 2; ++b)
#pragma unroll
                for (int m = 0; m < 4; ++m)
#pragma unroll
                    for (int n = 0; n < 2; ++n) acc[a][b][m][n] = (f32x4){0.f, 0.f, 0.f, 0.f};
        cur = nxt; cA = nA; cB = nB; ++ui; nt = S.unit_nt(cur, g.K / BK);
        if constexpr (ALIGN_EPI) { if (wr == 1) PG8_BAR; }
    }
    PG8_WAIT_V(0);
    if constexpr (!ALIGN_EPI) { if (wr == 0) PG8_BAR; }
    PG8_BAR;
    if constexpr (Epi::AFTER_DRAIN) { E.fused(acc, cur, wr, wc, fr, fq, lds, wid, lane); S.done(cur); }
#undef PG8_SA
#undef PG8_SB
#undef PG8_STAGE
#undef PG8_LDA
#undef PG8_LDB
#undef PG8_MMA
#undef PG8_WAIT_V
#undef PG8_WAIT_L
#undef PG8_BAR
#undef PG8_SCHED
}
}
#define DI __device__ __forceinline__
#define GAS __attribute__((address_space(1)))
#define LAS __attribute__((address_space(3)))
using pg8::bf16_t; using pg8::bf16x8; using pg8::f32x4; using pg8::u32x4;
typedef float f32x16 __attribute__((ext_vector_type(16)));
typedef float f32x2 __attribute__((ext_vector_type(2)));
typedef short s16x4 __attribute__((ext_vector_type(4)));
typedef unsigned u32x2 __attribute__((ext_vector_type(2)));
typedef __bf16 bf16x2_t __attribute__((ext_vector_type(2)));

constexpr int DM = 2048, NCTX = 8192, NDEC = 2048, MTOK = 10240, MKV = 10752;
constexpr int EVEN_IN = 4608, ODD_IN = 4960, ODD_INP = 5120, DFF = 5632, DFF2 = 11264;
constexpr float EPS = 1e-6f;
constexpr int NWAVES = 8, NTHR = 512;
enum { I_XP = 0, I_XS, I_CDAK, I_CDAV, I_CGQK, I_CGQV, I_CCKV, I_CKPE, I_SC, I_SN, I_SM, I_C, I_CCTX, I_N1G, I_N2G, I_WMOD, I_BMOD,
       I_EWIN, I_EWOUT, I_DALAM, I_DALN, I_GQQN, I_GQKN, I_OWIN, I_OWOUT, I_MLCW, I_MLCB, I_MLGB, I_MLNG, I_MLAQN, I_WUQ, I_MLAKVN, I_WUKV,
       I_FUP, I_FCW, I_FCB, I_FDN, I_FNG, N_IN };
constexpr size_t O_YP = 0, O_YS = 16777216, O_DAK = 20971520, O_DAV = 37748736, O_GQK = 54525952, O_GQV = 58720256, O_CKV = 62914560,
                 O_KPE = 67108864, O_MLC = 68157440, O_MLN = 84934656, O_MLM = 85065728, O_END = 85066752;
constexpr size_t MiB = 1u << 20;
constexpr size_t WS_CTL = 0, CTL_ZERO_BYTES = 65536;
constexpr size_t WS_MODRAW = 1 * MiB;
constexpr size_t WS_ROPE = 2 * MiB;
constexpr size_t WS_WIN = 4 * MiB, WIN_STRIDE = 20 * MiB;
constexpr size_t WS_WOUT = 84 * MiB, WOUT_STRIDE = 8 * MiB;
constexpr size_t WS_WUP = 116 * MiB, WUP_STRIDE = 44 * MiB;
constexpr size_t WS_WDN = 292 * MiB, WDN_STRIDE = 22 * MiB;
constexpr size_t WS_WUQ = 380 * MiB, WUQ_STRIDE = 1536 * 512 * 2;
constexpr size_t WS_WUKV = 383 * MiB, WUKV_STRIDE = 1 * MiB;
constexpr size_t WS_X = 386 * MiB;
constexpr size_t WS_H = 466 * MiB;
constexpr size_t WS_RAW = 506 * MiB;
constexpr size_t WS_MIX = 606 * MiB;
constexpr size_t WS_U = 646 * MiB;
constexpr size_t WS_ACT = 866 * MiB;
constexpr size_t WS_ATT = 976 * MiB;
constexpr size_t WE_KAD = WS_ATT + 0 * MiB;
constexpr size_t WE_KBD = WS_ATT + 5 * MiB;
constexpr size_t WE_VTA_C = WS_ATT + 8 * MiB;
constexpr size_t WE_VTA_D = WS_ATT + 24 * MiB;
constexpr size_t WE_VTB_C = WS_ATT + 30 * MiB;
constexpr size_t WE_VTB_D = WS_ATT + 34 * MiB;
constexpr size_t WO_QM = WS_ATT + 0 * MiB;
constexpr size_t WO_KM = WS_ATT + 20 * MiB;
constexpr size_t WO_KMT = WS_ATT + 40 * MiB;
constexpr size_t WO_VMT = WS_ATT + 60 * MiB;
constexpr size_t WO_G = WS_ATT + 80 * MiB;
constexpr size_t WO_QD = WS_ATT + 82 * MiB;
constexpr size_t WO_CKV = WS_ATT + 92 * MiB;
constexpr size_t WO_KPE = WS_ATT + 98 * MiB;
constexpr size_t WO_CQ = WS_ATT + 100 * MiB;
constexpr size_t WO_KV = WS_ATT + 130 * MiB;
constexpr size_t WO_VTM_C = WS_ATT + 172 * MiB;
constexpr size_t WO_VTM_D = WS_ATT + 188 * MiB;
constexpr size_t WO_HF = WS_ATT + 194 * MiB;
constexpr size_t WS_PART = WS_ATT + 274 * MiB;
constexpr size_t WS_END = WS_PART + 64 * MiB;
constexpr int RING_BYTES = 147456, LDSCTL_OFF = RING_BYTES, MISC_OFF = LDSCTL_OFF + 320, LDS_BYTES = 163840;

DI unsigned pk2(float lo, float hi) { f32x2 v = {lo, hi}; bf16x2_t b = __builtin_convertvector(v, bf16x2_t); return __builtin_bit_cast(unsigned, b); }
DI float bf_lo(unsigned w) { return __uint_as_float(w << 16); }
DI float bf_hi(unsigned w) { return __uint_as_float(w & 0xffff0000u); }
DI float bf2f(unsigned short h) { return __uint_as_float((unsigned)h << 16); }
DI void unpack8(const u32x4& w, float (&f)[8]) { f[0] = bf_lo(w.x); f[1] = bf_hi(w.x); f[2] = bf_lo(w.y); f[3] = bf_hi(w.y); f[4] = bf_lo(w.z); f[5] = bf_hi(w.z); f[6] = bf_lo(w.w); f[7] = bf_hi(w.w); }
DI u32x4 pack8(const float (&f)[8]) { u32x4 w; w.x = pk2(f[0], f[1]); w.y = pk2(f[2], f[3]); w.z = pk2(f[4], f[5]); w.w = pk2(f[6], f[7]); return w; }
template <int CTRL> DI float dppx(float v) { return __uint_as_float((unsigned)__builtin_amdgcn_update_dpp(0, (int)__float_as_uint(v), CTRL, 0xf, 0xf, true)); }
template <int PAT> DI float swz(float v) { return __uint_as_float((unsigned)__builtin_amdgcn_ds_swizzle((int)__float_as_uint(v), PAT)); }
DI float xor32_sum(float v) { const auto r = __builtin_amdgcn_permlane32_swap(__float_as_uint(v), __float_as_uint(v), false, false); return __uint_as_float(r[0]) + __uint_as_float(r[1]); }
DI float xor32_max(float v) { const auto r = __builtin_amdgcn_permlane32_swap(__float_as_uint(v), __float_as_uint(v), false, false); return fmaxf(__uint_as_float(r[0]), __uint_as_float(r[1])); }
DI float grp16_sum(float v) { v += dppx<0xB1>(v); v += dppx<0x4E>(v); v += dppx<0x141>(v); v += dppx<0x140>(v); return v; }
DI float wave_sum(float v) { v = grp16_sum(v); v += swz<0x401F>(v); return xor32_sum(v); }
template <int CTRL, int ROWMASK> DI float dppf(float oldv, float src) { return __uint_as_float((unsigned)__builtin_amdgcn_update_dpp((int)__float_as_uint(oldv), (int)__float_as_uint(src), CTRL, ROWMASK, 0xf, false)); }
DI float wave_scan_sum(float x) {
    x += dppf<0x111, 0xf>(0.f, x); x += dppf<0x112, 0xf>(0.f, x); x += dppf<0x114, 0xf>(0.f, x); x += dppf<0x118, 0xf>(0.f, x);
    x += dppf<0x142, 0xa>(0.f, x); x += dppf<0x143, 0xc>(0.f, x); return x; }
DI float wave_scan_max(float x) { const float ninf = -3.0e38f;
    x = fmaxf(x, dppf<0x111, 0xf>(ninf, x)); x = fmaxf(x, dppf<0x112, 0xf>(ninf, x)); x = fmaxf(x, dppf<0x114, 0xf>(ninf, x)); x = fmaxf(x, dppf<0x118, 0xf>(ninf, x));
    x = fmaxf(x, dppf<0x142, 0xa>(ninf, x)); x = fmaxf(x, dppf<0x143, 0xc>(ninf, x)); return x; }
DI int crow(int r, int hi) { return (r & 3) + 8 * (r >> 2) + 4 * hi; }
DI float fexp(float x) { return __builtin_amdgcn_exp2f(x * 1.4426950408889634f); }
DI float frcp(float x) { return __builtin_amdgcn_rcpf(x); }
DI float frsq(float x) { return __builtin_amdgcn_rsqf(x); }
DI float sigmoidf_(float x) { return frcp(1.0f + fexp(-x)); }
DI float siluf_(float x) { return x * frcp(1.0f + fexp(-x)); }
DI float log1p_(float t) { const float a = t * (1.0f - 0.5f * t), b = __builtin_amdgcn_logf(1.0f + t) * 0.6931471805599453f; return t < 1e-3f ? a : b; }
DI float logsigmoidf_(float x) { const float t = fexp(-fabsf(x)); return fminf(x, 0.f) - log1p_(t); }
#define MFMA32(a, b, c) __builtin_amdgcn_mfma_f32_32x32x16_bf16((a), (b), (c), 0, 0, 0)
DI bf16x8 cat4(s16x4 lo, s16x4 hi) { return __builtin_shufflevector(lo, hi, 0, 1, 2, 3, 4, 5, 6, 7); }
DI bf16x8 pack_step(const f32x16& x, int s) {
    u32x4 p; p.x = pk2(x[8 * s + 0], x[8 * s + 1]); p.y = pk2(x[8 * s + 2], x[8 * s + 3]); p.z = pk2(x[8 * s + 4], x[8 * s + 5]); p.w = pk2(x[8 * s + 6], x[8 * s + 7]);
    return __builtin_bit_cast(bf16x8, p);
}
DI void row_info(int row, int& b, int& t, int& T, int& v) {
    if (row < NCTX) { b = row >> 8; t = row & 255; T = 256; v = 0; } else { const int r = row - NCTX; b = r >> 10; t = r & 1023; T = 1024; v = 1 + b; }
}

struct EpiResid {
    static constexpr bool PERM = true, AFTER_DRAIN = false, ROWPERM = false;
    const void* base; int base_f32; bf16_t* out; const float* gate;
    __device__ __forceinline__ void operator()(const f32x4 (&acc)[2][2][4][2], const pg8::Unit& u, int wr, int wc, int fr, int fq) const {
        const int row0 = u.pm * 256 + wr * 64 + fr, col0 = u.pn * 256 + wc * 32 + 8 * fq;
        const int v = (u.pm < 32) ? 0 : 1 + ((u.pm - 32) >> 2);
        const float* gr = gate + (size_t)v * 12288;
        f32x4 g4[2][2];
#pragma unroll
        for (int bj = 0; bj < 2; ++bj)
#pragma unroll
            for (int n = 0; n < 2; ++n) g4[bj][n] = *(const f32x4*)(gr + col0 + bj * 128 + n * 4);
        if (base_f32) {
            const float* bf = (const float*)base;
#pragma unroll
            for (int am = 0; am < 8; ++am) {
                const int row = row0 + (am >> 2) * 128 + (am & 3) * 16; f32x4 bv[2][2];
#pragma unroll
                for (int bj = 0; bj < 2; ++bj)
#pragma unroll
                    for (int n = 0; n < 2; ++n) bv[bj][n] = *(const f32x4*)(bf + (size_t)row * DM + col0 + bj * 128 + n * 4);
#pragma unroll
                for (int bj = 0; bj < 2; ++bj) { const f32x4 y0 = bv[bj][0] + g4[bj][0] * acc[am >> 2][bj][am & 3][0], y1 = bv[bj][1] + g4[bj][1] * acc[am >> 2][bj][am & 3][1];
                    u32x4 w; w.x = pk2(y0.x, y0.y); w.y = pk2(y0.z, y0.w); w.z = pk2(y1.x, y1.y); w.w = pk2(y1.z, y1.w); *(u32x4*)(out + (size_t)row * DM + col0 + bj * 128) = w; }
            }
        } else {
            const bf16_t* bb = (const bf16_t*)base;
#pragma unroll
            for (int am = 0; am < 2; ++am) {
                u32x4 bv[4][2];
#pragma unroll
                for (int m = 0; m < 4; ++m)
#pragma unroll
                    for (int bj = 0; bj < 2; ++bj) bv[m][bj] = *(const u32x4*)(bb + (size_t)(row0 + am * 128 + m * 16) * DM + col0 + bj * 128);
#pragma unroll
                for (int m = 0; m < 4; ++m)
#pragma unroll
                    for (int bj = 0; bj < 2; ++bj) { float f[8]; unpack8(bv[m][bj], f); const f32x4 a0 = acc[am][bj][m][0], a1 = acc[am][bj][m][1];
                        f[0] += g4[bj][0].x * a0.x; f[1] += g4[bj][0].y * a0.y; f[2] += g4[bj][0].z * a0.z; f[3] += g4[bj][0].w * a0.w;
                        f[4] += g4[bj][1].x * a1.x; f[5] += g4[bj][1].y * a1.y; f[6] += g4[bj][1].z * a1.z; f[7] += g4[bj][1].w * a1.w;
                        *(u32x4*)(out + (size_t)(row0 + am * 128 + m * 16) * DM + col0 + bj * 128) = pack8(f); }
            }
        }
    }
};

struct EpiUp {
    static constexpr bool PERM = true, AFTER_DRAIN = false, ROWPERM = true;
    float* HALO; bf16_t* ACT; const float* cw; const float* cb; LAS float* xch;
    __device__ __forceinline__ void operator()(const f32x4 (&acc)[2][2][4][2], const pg8::Unit& u, int wr, int wc, int fr, int fq) const {
        const int tok0 = u.pm * 256 + 8 * (16 * wr + fr);
        const int ch0 = u.pn * 128 + wc * 32 + 8 * fq;
        f32x4 w0[2], w1[2], w2[2], bb[2];
#pragma unroll
        for (int bj = 0; bj < 2; ++bj) { const int cc = bj * DFF + ch0; w0[bj] = *(const f32x4*)(cw + cc); w1[bj] = *(const f32x4*)(cw + DFF2 + cc); w2[bj] = *(const f32x4*)(cw + 2 * DFF2 + cc); bb[bj] = *(const f32x4*)(cb + cc); }
        if (u.pm >= 32) {
            float* hb = HALO + (size_t)(u.pm - 32) * 8 * DFF + ch0;
            if (wr == 0 && fr == 0) {
#pragma unroll
                for (int r = 0; r < 2; ++r)
#pragma unroll
                    for (int bj = 0; bj < 2; ++bj)
#pragma unroll
                        for (int n = 0; n < 2; ++n) *(f32x4*)(hb + (size_t)(r * 2 + bj) * DFF + 4 * n) = acc[0][bj][r][n]; }
            if (wr == 1 && fr == 15) {
#pragma unroll
                for (int r = 2; r < 4; ++r)
#pragma unroll
                    for (int bj = 0; bj < 2; ++bj)
#pragma unroll
                        for (int n = 0; n < 2; ++n) *(f32x4*)(hb + (size_t)(r * 2 + bj) * DFF + 4 * n) = acc[1][bj][r][n]; }
        }
        float pv[2][8], nx[2][8];
#pragma unroll
        for (int bj = 0; bj < 2; ++bj)
#pragma unroll
            for (int c = 0; c < 8; ++c) { pv[bj][c] = dppx<0x111>(acc[1][bj][3][c >> 2][c & 3]); nx[bj][c] = dppx<0x101>(acc[0][bj][0][c >> 2][c & 3]);     }
        LAS f32x4* X = (LAS f32x4*)xch;
        if (fr == 0) { LAS f32x4* p = X + (((0 * 2 + wr) * 4 + wc) * 4 + fq) * 4; p[0] = acc[0][0][0][0]; p[1] = acc[0][0][0][1]; p[2] = acc[0][1][0][0]; p[3] = acc[0][1][0][1]; }
        if (fr == 15) { LAS f32x4* p = X + (((1 * 2 + wr) * 4 + wc) * 4 + fq) * 4; p[0] = acc[1][0][3][0]; p[1] = acc[1][0][3][1]; p[2] = acc[1][1][3][0]; p[3] = acc[1][1][3][1]; }
        asm volatile("s_waitcnt lgkmcnt(0)" ::: "memory"); __builtin_amdgcn_s_barrier(); asm volatile("" ::: "memory");
        if (fr == 0) {
            if (wr == 1) { const LAS f32x4* p = X + (((1 * 2 + 0) * 4 + wc) * 4 + fq) * 4; const f32x4 a = p[0], b = p[1], c = p[2], d = p[3];
                pv[0][0] = a[0]; pv[0][1] = a[1]; pv[0][2] = a[2]; pv[0][3] = a[3]; pv[0][4] = b[0]; pv[0][5] = b[1]; pv[0][6] = b[2]; pv[0][7] = b[3];
                pv[1][0] = c[0]; pv[1][1] = c[1]; pv[1][2] = c[2]; pv[1][3] = c[3]; pv[1][4] = d[0]; pv[1][5] = d[1]; pv[1][6] = d[2]; pv[1][7] = d[3]; }
            else {
#pragma unroll
                for (int c = 0; c < 8; ++c) { pv[0][c] = 0.f; pv[1][c] = 0.f; } }
        }
        if (fr == 15) {
            if (wr == 0) { const LAS f32x4* p = X + (((0 * 2 + 1) * 4 + wc) * 4 + fq) * 4; const f32x4 a = p[0], b = p[1], c = p[2], d = p[3];
                nx[0][0] = a[0]; nx[0][1] = a[1]; nx[0][2] = a[2]; nx[0][3] = a[3]; nx[0][4] = b[0]; nx[0][5] = b[1]; nx[0][6] = b[2]; nx[0][7] = b[3];
                nx[1][0] = c[0]; nx[1][1] = c[1]; nx[1][2] = c[2]; nx[1][3] = c[3]; nx[1][4] = d[0]; nx[1][5] = d[1]; nx[1][6] = d[2]; nx[1][7] = d[3]; }
            else {
#pragma unroll
                for (int c = 0; c < 8; ++c) { nx[0][c] = 0.f; nx[1][c] = 0.f; } }
        }
        u32x2 keep[8];
#pragma unroll
        for (int n = 0; n < 2; ++n) {
            if (n == 1) {
#pragma unroll
                for (int bj = 0; bj < 2; ++bj) { const int cc = bj * DFF + ch0 + 4; w0[bj] = *(const f32x4*)(cw + cc); w1[bj] = *(const f32x4*)(cw + DFF2 + cc); w2[bj] = *(const f32x4*)(cw + 2 * DFF2 + cc); bb[bj] = *(const f32x4*)(cb + cc); } }
#pragma unroll
            for (int k = 0; k < 8; ++k) {
                float y[4];
#pragma unroll
                for (int e = 0; e < 4; ++e) { const int c = 4 * n + e; float cv[2];
#pragma unroll
                    for (int bj = 0; bj < 2; ++bj) { const float xm = (k == 0) ? pv[bj][c] : acc[(k - 1) >> 2][bj][(k - 1) & 3][n][e], xc = acc[k >> 2][bj][k & 3][n][e], xp = (k == 7) ? nx[bj][c] : acc[(k + 1) >> 2][bj][(k + 1) & 3][n][e];
                        cv[bj] = bb[bj][e] + w0[bj][e] * xm + w1[bj][e] * xc + w2[bj][e] * xp; }
                    y[e] = siluf_(cv[0]) * cv[1]; }
                u32x2 w; w.x = pk2(y[0], y[1]); w.y = pk2(y[2], y[3]);
                if (n == 0) keep[k] = w; else *(u32x4*)(ACT + (size_t)(tok0 + k) * DFF + ch0) = (u32x4){keep[k].x, keep[k].y, w.x, w.y};
            }
        }
    }
};
struct EpiPart {
    static constexpr bool PERM = true, AFTER_DRAIN = false, ROWPERM = false;
    bf16_t* P;
    __device__ __forceinline__ void operator()(const f32x4 (&acc)[2][2][4][2], const pg8::Unit& u, int wr, int wc, int fr, int fq) const {
        const int row0 = u.pm * 256 + wr * 64 + fr, col0 = u.pn * 256 + wc * 32 + 8 * fq; bf16_t* base = P + (size_t)u.ks * NDEC * DM;
#pragma unroll
        for (int ai = 0; ai < 2; ++ai)
#pragma unroll
            for (int m = 0; m < 4; ++m) { bf16_t* op = base + (size_t)(row0 + ai * 128 + m * 16) * DM;
#pragma unroll
                for (int bj = 0; bj < 2; ++bj) { const f32x4 a = acc[ai][bj][m][0], c = acc[ai][bj][m][1]; u32x4 w; w.x = pk2(a.x, a.y); w.y = pk2(a.z, a.w); w.z = pk2(c.x, c.y); w.w = pk2(c.z, c.w); *(u32x4*)(op + col0 + bj * 128) = w; } }
    }
};
struct OutOrder {
    int G, c, Kq;
    __device__ __forceinline__ bool next(int i, pg8::Unit& u) const {
        int J;
        if (G == 256) { if (i >= 2) return false; J = (i == 0) ? c : 256 + c; }
        else { J = i * G + c; if (J >= 512) return false; }
        const int L = J & 255; const bool lat = J >= 256;
        const int w = (L & 7) * 32 + (L >> 3);
        u.pm = lat ? 32 + (L >> 5) : (w >> 6) * 8 + (w & 7); u.pn = lat ? (L >> 2) & 7 : (w & 63) >> 3; u.ks = lat ? L & 3 : 0; u.koff = lat ? (L & 3) * Kq : 0; return true;
    }
    __device__ __forceinline__ void a_ready(const pg8::Unit&) const {}
    __device__ __forceinline__ void done(const pg8::Unit&) const {}
    __device__ __forceinline__ int unit_nt(const pg8::Unit& u, int nt_gemm) const { return u.pm >= 32 ? Kq / pg8::BK : nt_gemm; }
    __device__ __forceinline__ int latent_of(int i) const { if (G == 256) return i == 1 ? c : -1; const int J = i * G + c; return (J >= 256 && J < 512) ? J - 256 : -1; }
};
DI void ffn_edge_fix(int L, const float* HALO, const float* cw, const float* cb, bf16_t* ACT, int tid) {
    const int pt = L >> 5, ks = L & 3, q = pt & 3;
    for (int idx = tid; idx < 2 * (DFF / 4); idx += NTHR) {
        const int side = idx >= DFF / 4 ? 1 : 0, ch = ks * (DFF / 4) + idx - side * (DFF / 4);
        if (side ? (q == 3) : (q == 0)) continue;
        const float* hm = HALO + (size_t)(side ? pt * 4 + 2 : (pt - 1) * 4 + 3) * 2 * DFF + ch;
        const float* hc = HALO + (size_t)(side ? pt * 4 + 3 : pt * 4 + 0) * 2 * DFF + ch;
        const float* hp = HALO + (size_t)(side ? (pt + 1) * 4 + 0 : pt * 4 + 1) * 2 * DFF + ch;
        float cv[2];
#pragma unroll
        for (int bj = 0; bj < 2; ++bj) { const int cc = bj * DFF + ch; cv[bj] = cb[cc] + cw[cc] * hm[bj * DFF] + cw[DFF2 + cc] * hc[bj * DFF] + cw[2 * DFF2 + cc] * hp[bj * DFF]; }
        const float y = siluf_(cv[0]) * cv[1];
        ACT[(size_t)(NCTX + pt * 256 + (side ? 255 : 0)) * DFF + ch] = (bf16_t)(pk2(y, y) & 0xffffu);
    }
}
struct EpiResPart {
    static constexpr bool PERM = true, AFTER_DRAIN = false, ROWPERM = false;
    EpiResid R; EpiPart Pq;
    __device__ __forceinline__ void operator()(const f32x4 (&acc)[2][2][4][2], const pg8::Unit& u, int wr, int wc, int fr, int fq) const {
        if (u.pm < 32) R(acc, u, wr, wc, fr, fq);
        else Pq(acc, u, wr, wc, fr, fq);
    }
};

struct InOrder {
    pg8::StaticOrder S0; int G, c, nW, nQ;
    __device__ __forceinline__ bool next(int i, pg8::Unit& u) const {
        pg8::Unit t; const bool w = S0.next(i, t); const int q = i * G + c - nW;
        if (!w && q >= nQ) return false;
        u.pm = w ? t.pm : q >> 2; u.pn = w ? t.pn : S0.nN; u.ks = w ? 0 : q & 3; u.koff = w ? 0 : (q & 3) * 512; return true;
    }
    __device__ __forceinline__ void a_ready(const pg8::Unit&) const {}
    __device__ __forceinline__ void done(const pg8::Unit&) const {}
    __device__ __forceinline__ int unit_nt(const pg8::Unit& u, int nt_gemm) const { return u.pn >= S0.nN ? 512 / pg8::BK : nt_gemm; }
};
struct EpiInQ {
    static constexpr bool PERM = true, AFTER_DRAIN = false, ROWPERM = false;
    pg8::EpiBf16<0> E0; bf16_t* P2; int npw;
    __device__ __forceinline__ void operator()(const f32x4 (&acc)[2][2][4][2], const pg8::Unit& u, int wr, int wc, int fr, int fq) const {
        if (u.pn < npw) { E0(acc, u, wr, wc, fr, fq); return; }
        bf16_t* base = P2 + ((size_t)u.ks * MTOK + u.pm * 256 + wr * 64 + fr) * 128 + wc * 32 + 8 * fq;
#pragma unroll
        for (int ai = 0; ai < 2; ++ai)
#pragma unroll
            for (int m = 0; m < 4; ++m) { const f32x4 v0 = acc[ai][0][m][0], v1 = acc[ai][0][m][1]; u32x4 w; w.x = pk2(v0[0], v0[1]); w.y = pk2(v0[2], v0[3]); w.z = pk2(v1[0], v1[1]); w.w = pk2(v1[2], v1[3]);
                *(u32x4*)(base + (size_t)(ai * 128 + m * 16) * 128) = w; }
    }
};

DI void p0_tr64(const float* W, int K, int N, bf16_t* WT, int item, int lane, int perm, LAS unsigned char* lw) {
    const int nblk = (N + 63) >> 6, gpr = (nblk + 3) >> 2, g8 = item >> 3, e8 = item & 7, kb = 2 * (g8 / gpr) + (e8 >> 2), nb = 4 * (g8 % gpr) + (e8 & 3), k0 = kb * 64, n = nb * 64 + lane; const bool ok = n < N;
    if (nb >= nblk) return;
    const float* p = W + (size_t)k0 * N + (ok ? n : 0);
    float v[64];
#pragma unroll
    for (int i = 0; i < 64; ++i) v[i] = p[(size_t)i * N];
#pragma unroll
    for (int c = 0; c < 8; ++c) { u32x4 o; o.x = pk2(v[8 * c], v[8 * c + 1]); o.y = pk2(v[8 * c + 2], v[8 * c + 3]); o.z = pk2(v[8 * c + 4], v[8 * c + 5]); o.w = pk2(v[8 * c + 6], v[8 * c + 7]); *(LAS u32x4*)(lw + lane * 144 + c * 16) = o; }
#pragma unroll
    for (int i = 0; i < 8; ++i) { const int r = 8 * i + (lane >> 3), nn = nb * 64 + r; const u32x4 o = *(const LAS u32x4*)(lw + r * 144 + (lane & 7) * 16);
        const int half = (nn >= DFF) ? 1 : 0, ch = nn - half * DFF, nrow = (perm == 1) ? ((ch >> 7) * 256 + half * 128 + (ch & 127)) : (perm == 2) ? (nn < 4096 ? nn : (nn < 4128 ? nn + 832 : nn - 32)) : nn;
        if (nn < N) *(u32x4*)(WT + (size_t)nrow * K + k0 + (lane & 7) * 8) = o; }
}
DI void rope_table_entry(float* tab, int i) {
    const int pos = i >> 5, k = i & 31;
    const float invf = __builtin_amdgcn_exp2f(-(float)k * (13.287712379549449f / 32.0f));
    const double a = (double)invf, a2 = a * a;
    double c = 1.0, s = a, tc = 1.0, ts = a;
#pragma unroll
    for (int n = 1; n <= 11; ++n) { tc *= -a2 / (double)((2 * n - 1) * (2 * n)); ts *= -a2 / (double)((2 * n) * (2 * n + 1)); c += tc; s += ts; }
    double cr = 1.0, sr = 0.0;
    for (int p = 0; p < pos; ++p) { const double cn = cr * c - sr * s, sn = cr * s + sr * c; cr = cn; sr = sn; }
    tab[2 * i] = (float)cr; tab[2 * i + 1] = (float)sr;
}

DI void row_sum_partials(const u32x4 (&q)[4], float (&p)[8]) { float a[8], b[8], c[8], d[8]; unpack8(q[0], a); unpack8(q[1], b); unpack8(q[2], c); unpack8(q[3], d);
#pragma unroll
    for (int e = 0; e < 8; ++e) p[e] = (a[e] + b[e]) + (c[e] + d[e]); }
DI void norm_mod_rows(const void* xc, int cf32, const void* xd, int df32, const float* g, const float* mod, int which, bf16_t* H, const float* fixg, const bf16_t* P, bf16_t* Xw, int gw, int ngw, int lane) {
    for (int row = gw; row < MTOK; row += ngw) {
        const bool dec = row >= NCTX; const int rr = dec ? row - NCTX : row;
        const int v = dec ? 1 + (rr >> 10) : 0;
        const float* sh = mod + (size_t)v * 12288 + which * 2048;
        float x[4][8];
        if (dec ? df32 : cf32) { const float* xr = (const float*)(dec ? xd : xc) + (size_t)rr * DM; f32x4 ra[4], rb[4];
#pragma unroll
            for (int jj = 0; jj < 4; ++jj) { ra[jj] = *(const f32x4*)(xr + (lane + 64 * jj) * 8); rb[jj] = *(const f32x4*)(xr + (lane + 64 * jj) * 8 + 4); }
#pragma unroll
            for (int jj = 0; jj < 4; ++jj) { x[jj][0] = ra[jj].x; x[jj][1] = ra[jj].y; x[jj][2] = ra[jj].z; x[jj][3] = ra[jj].w; x[jj][4] = rb[jj].x; x[jj][5] = rb[jj].y; x[jj][6] = rb[jj].z; x[jj][7] = rb[jj].w; }
        } else { const bf16_t* xr = (const bf16_t*)(dec ? xd : xc) + (size_t)rr * DM; u32x4 rw[4];
#pragma unroll
            for (int jj = 0; jj < 4; ++jj) rw[jj] = *(const u32x4*)(xr + (lane + 64 * jj) * 8);
#pragma unroll
            for (int jj = 0; jj < 4; ++jj) unpack8(rw[jj], x[jj]);
        }
        const bool fix = dec && fixg;
        if (fix) {
            const bf16_t* pr = P + (size_t)rr * DM; const float* fg = fixg + (size_t)v * 12288;
            u32x4 q[4][4]; f32x4 fa[4], fb[4];
#pragma unroll
            for (int jj = 0; jj < 4; ++jj) { const int c = (lane + 64 * jj) * 8;
#pragma unroll
                for (int k = 0; k < 4; ++k) q[jj][k] = *(const u32x4*)(pr + (size_t)k * NDEC * DM + c);
                fa[jj] = *(const f32x4*)(fg + c); fb[jj] = *(const f32x4*)(fg + c + 4); }
#pragma unroll
            for (int jj = 0; jj < 4; ++jj) { float p[8]; row_sum_partials(q[jj], p);
                x[jj][0] += fa[jj].x * p[0]; x[jj][1] += fa[jj].y * p[1]; x[jj][2] += fa[jj].z * p[2]; x[jj][3] += fa[jj].w * p[3];
                x[jj][4] += fb[jj].x * p[4]; x[jj][5] += fb[jj].y * p[5]; x[jj][6] += fb[jj].z * p[6]; x[jj][7] += fb[jj].w * p[7]; }
        }
        f32x4 ga[4], gb[4], sfa[4], sfb[4], sca[4], scb[4];
#pragma unroll
        for (int jj = 0; jj < 4; ++jj) { const int c = (lane + 64 * jj) * 8; ga[jj] = *(const f32x4*)(g + c); gb[jj] = *(const f32x4*)(g + c + 4); sfa[jj] = *(const f32x4*)(sh + c); sfb[jj] = *(const f32x4*)(sh + c + 4);
            sca[jj] = *(const f32x4*)(sh + 2048 + c); scb[jj] = *(const f32x4*)(sh + 2048 + c + 4); }
        if (fix) {
#pragma unroll
            for (int jj = 0; jj < 4; ++jj) *(u32x4*)(Xw + (size_t)row * DM + (lane + 64 * jj) * 8) = pack8(x[jj]);
        }
        float ss = 0.f;
#pragma unroll
        for (int jj = 0; jj < 4; ++jj)
#pragma unroll
            for (int e = 0; e < 8; ++e) ss += x[jj][e] * x[jj][e];
        ss = wave_sum(ss);
        const float rstd = frsq(ss * (1.0f / DM) + EPS);
        u32x4 o[4];
#pragma unroll
        for (int jj = 0; jj < 4; ++jj) { float y[8];
#pragma unroll
            for (int e = 0; e < 4; ++e) { y[e] = x[jj][e] * rstd * ga[jj][e] * (sca[jj][e] + 1.0f) + sfa[jj][e]; y[4 + e] = x[jj][4 + e] * rstd * gb[jj][e] * (scb[jj][e] + 1.0f) + sfb[jj][e]; }
            o[jj] = pack8(y); }
#pragma unroll
        for (int jj = 0; jj < 4; ++jj) *(u32x4*)(H + (size_t)row * DM + (lane + 64 * jj) * 8) = o[jj];
    }
}
DI void final_norm_rows(const bf16_t* X, const float* g, float* out, const float* fixg, const bf16_t* P, int gw, int ngw, int lane) {
    for (int row = gw; row < MTOK; row += ngw) {
        const bf16_t* xr = X + (size_t)row * DM; u32x4 rw[4]; float x[4][8];
#pragma unroll
        for (int jj = 0; jj < 4; ++jj) rw[jj] = *(const u32x4*)(xr + (lane + 64 * jj) * 8);
#pragma unroll
        for (int jj = 0; jj < 4; ++jj) unpack8(rw[jj], x[jj]);
        if (row >= NCTX) { const int rr = row - NCTX, v = 1 + (rr >> 10); const bf16_t* pr = P + (size_t)rr * DM; const float* fg = fixg + (size_t)v * 12288;
            u32x4 q[4][4]; f32x4 fa[4], fb[4];
#pragma unroll
            for (int jj = 0; jj < 4; ++jj) { const int c = (lane + 64 * jj) * 8;
#pragma unroll
                for (int k = 0; k < 4; ++k) q[jj][k] = *(const u32x4*)(pr + (size_t)k * NDEC * DM + c);
                fa[jj] = *(const f32x4*)(fg + c); fb[jj] = *(const f32x4*)(fg + c + 4); }
#pragma unroll
            for (int jj = 0; jj < 4; ++jj) { float p[8]; row_sum_partials(q[jj], p);
                x[jj][0] += fa[jj].x * p[0]; x[jj][1] += fa[jj].y * p[1]; x[jj][2] += fa[jj].z * p[2]; x[jj][3] += fa[jj].w * p[3];
                x[jj][4] += fb[jj].x * p[4]; x[jj][5] += fb[jj].y * p[5]; x[jj][6] += fb[jj].z * p[6]; x[jj][7] += fb[jj].w * p[7]; } }
        float ss = 0.f;
#pragma unroll
        for (int jj = 0; jj < 4; ++jj)
#pragma unroll
            for (int e = 0; e < 8; ++e) ss += x[jj][e] * x[jj][e];
        ss = wave_sum(ss);
        const float rstd = frsq(ss * (1.0f / DM) + EPS);
#pragma unroll
        for (int jj = 0; jj < 4; ++jj) { const int c = (lane + 64 * jj) * 8; const f32x4 g0 = *(const f32x4*)(g + c), g1 = *(const f32x4*)(g + c + 4);
            *(f32x4*)(out + (size_t)row * DM + c) = (f32x4){x[jj][0] * rstd * g0.x, x[jj][1] * rstd * g0.y, x[jj][2] * rstd * g0.z, x[jj][3] * rstd * g0.w};
            *(f32x4*)(out + (size_t)row * DM + c + 4) = (f32x4){x[jj][4] * rstd * g1.x, x[jj][5] * rstd * g1.y, x[jj][6] * rstd * g1.z, x[jj][7] * rstd * g1.w}; }
    }
}

template <int DIMQ> DI void rope_chunk(float (&f)[8], int ci, const float* tab, int pr, int pc) {
    constexpr int CPQ = DIMQ / 8;
    const bool x2 = (ci & CPQ) != 0; const int part = ci / (2 * CPQ); const int iq0 = (ci & (CPQ - 1)) * 8;
    const int pos = part ? pc : pr;
    float p[8];
#pragma unroll
    for (int e = 0; e < 8; ++e) { if constexpr (CPQ == 2) p[e] = dppx<0x4E>(f[e]); else p[e] = swz<0x101F>(f[e]); }
#pragma unroll
    for (int e = 0; e < 8; ++e) { const int k = (DIMQ == 16) ? 2 * (iq0 + e) : (iq0 + e); const f32x2 cs = *(const f32x2*)(tab + (size_t)(pos * 32 + k) * 2);
        f[e] = x2 ? (p[e] * cs.y + f[e] * cs.x) : (f[e] * cs.x - p[e] * cs.y); }
}
DI void transpose64_bf16(const bf16_t* srow, bf16_t* dst, size_t ld) {
#pragma unroll
    for (int ch = 0; ch < 8; ++ch) { const u32x4 w = *(const u32x4*)(srow + ch * 8);
#pragma unroll
        for (int e = 0; e < 8; ++e) { const unsigned ww = w[e >> 1]; dst[(size_t)(ch * 8 + e) * ld] = (bf16_t)((e & 1) ? (ww >> 16) : (ww & 0xffffu)); } }
}
DI void transpose64_f32(const float* srow, bf16_t* dst, size_t ld) {
#pragma unroll
    for (int ch = 0; ch < 8; ++ch) { const f32x4 a = *(const f32x4*)(srow + ch * 8), b = *(const f32x4*)(srow + ch * 8 + 4);
        const unsigned w0 = pk2(a.x, a.y), w1 = pk2(a.z, a.w), w2 = pk2(b.x, b.y), w3 = pk2(b.z, b.w);
        dst[(size_t)(ch * 8 + 0) * ld] = (bf16_t)(w0 & 0xffffu); dst[(size_t)(ch * 8 + 1) * ld] = (bf16_t)(w0 >> 16);
        dst[(size_t)(ch * 8 + 2) * ld] = (bf16_t)(w1 & 0xffffu); dst[(size_t)(ch * 8 + 3) * ld] = (bf16_t)(w1 >> 16);
        dst[(size_t)(ch * 8 + 4) * ld] = (bf16_t)(w2 & 0xffffu); dst[(size_t)(ch * 8 + 5) * ld] = (bf16_t)(w2 >> 16);
        dst[(size_t)(ch * 8 + 6) * ld] = (bf16_t)(w3 & 0xffffu); dst[(size_t)(ch * 8 + 7) * ld] = (bf16_t)(w3 >> 16); }
}
#define XB_TMO      128
#define XB_XCNT(j)  (256  + 64 * (j))
#define XB_XSUB(j)  (1280 + 64 * (j))
#define XB_XGEN(j)  (2304 + 64 * (j))
#define XB_TOP      3328
#define XB_TOPGEN   3392
#define XCD_BAR_WORDS 3456
#define XB_SPIN_CAP (1u << 22)

__device__ __forceinline__ unsigned xb_ld(unsigned* p)              { return __hip_atomic_load(p, __ATOMIC_RELAXED, __HIP_MEMORY_SCOPE_AGENT); }
__device__ __forceinline__ unsigned xb_add(unsigned* p, unsigned v) { return __hip_atomic_fetch_add(p, v, __ATOMIC_RELAXED, __HIP_MEMORY_SCOPE_AGENT); }
__device__ __forceinline__ unsigned xb_xcc_id() { return (unsigned)__builtin_amdgcn_s_getreg((3 << 11) | 20) & 0xFu; }
#define XB_SPIN(cond, bar) do { unsigned _sp = 0; while (cond) { __builtin_amdgcn_s_sleep(1); \
    if ((++_sp & 255u) == 0u) { if (xb_ld(&(bar)[XB_TMO])) break; if (_sp > XB_SPIN_CAP) { atomicAdd(&(bar)[XB_TMO], 1u); break; } } } } while (0)

struct XcdBarrier {
    unsigned* bar; unsigned x;
    volatile LAS unsigned* st;
};

__device__ __forceinline__ XcdBarrier xcd_barrier_post(unsigned* bar, volatile LAS unsigned* st) {
    XcdBarrier b; b.bar = bar; b.x = (unsigned)__builtin_amdgcn_readfirstlane((int)xb_xcc_id()); b.st = st;
    if (threadIdx.x == 0) (void)xb_add(&bar[XB_XCNT(b.x)], 1u);
    return b;
}
__device__ __forceinline__ void xcd_barrier_complete(unsigned* bar, unsigned x, unsigned& nloc, unsigned& nx) {
    const unsigned G = gridDim.x * gridDim.y * gridDim.z;
    unsigned sum, cnt, mine, sp = 0u;
    for (;;) {
        sum = 0u; cnt = 0u; mine = 0u;
#pragma unroll
        for (unsigned j = 0; j < 16; ++j) { const unsigned c = xb_ld(&bar[XB_XCNT(j)]); sum += c; cnt += (c > 0u) ? 1u : 0u; mine = (j == x) ? c : mine; }
        if (sum == G) break;
        __builtin_amdgcn_s_sleep(1);
        if ((++sp & 255u) == 0u) { if (xb_ld(&bar[XB_TMO])) break; if (sp > XB_SPIN_CAP) { atomicAdd(&bar[XB_TMO], 1u); break; } }
    }
    nloc = mine > 0u ? mine : 1u; nx = cnt > 0u ? cnt : 1u;
}

__device__ __forceinline__ void xcd_barrier(const XcdBarrier& b, const int tid_) {
    asm volatile("s_waitcnt vmcnt(0)" ::: "memory");
    __syncthreads();
    if (tid_ == 0) {
        unsigned* bar = b.bar; unsigned bx = b.x; asm volatile("" : "+s"(bar), "+s"(bx));
        __builtin_amdgcn_s_waitcnt(0);
        unsigned nloc = b.st[0], nx = b.st[1];
        if (nloc == 0u) { xcd_barrier_complete(bar, bx, nloc, nx); b.st[0] = nloc; b.st[1] = nx; }
        const unsigned old = xb_add(&bar[XB_XSUB(bx)], 1u);
        const unsigned gen = old / nloc;
        if (old + 1u == (gen + 1u) * nloc) {
            __builtin_amdgcn_fence(__ATOMIC_RELEASE, "agent");
            asm volatile("s_waitcnt vmcnt(0)" ::: "memory");
            const unsigned og = xb_add(&bar[XB_TOP], 1u);
            const unsigned tg = og / nx;
            if (og + 1u == (tg + 1u) * nx) {
#pragma unroll
                for (unsigned j = 0; j < 16; ++j) xb_add(&bar[XB_XGEN(j)], 1u);
                __builtin_amdgcn_fence(__ATOMIC_ACQUIRE, "agent");
            } else { __builtin_amdgcn_fence(__ATOMIC_ACQUIRE, "agent");
                   XB_SPIN(xb_ld(&bar[XB_XGEN(bx)]) == gen, bar); }
            asm volatile("s_waitcnt vmcnt(0)" ::: "memory");
        } else {
            __builtin_amdgcn_fence(__ATOMIC_ACQUIRE, "agent");
            XB_SPIN(xb_ld(&bar[XB_XGEN(bx)]) == gen, bar);
            asm volatile("s_waitcnt vmcnt(0)" ::: "memory");
        }
    }
    __syncthreads();
}

__device__ __forceinline__ void xcd_barrier_fast(const XcdBarrier& b, const int tid_) {
    asm volatile("s_waitcnt vmcnt(0)" ::: "memory");
    __syncthreads();
    if (tid_ == 0) {
        unsigned* bar = b.bar; unsigned bx = b.x; asm volatile("" : "+s"(bar), "+s"(bx));
        __builtin_amdgcn_s_waitcnt(0);
        unsigned nloc = b.st[0], nx = b.st[1];
        const unsigned old = xb_add(&bar[XB_XSUB(bx)], 1u);
        const unsigned gen = old / nloc;
        if (old + 1u == (gen + 1u) * nloc) {
            __builtin_amdgcn_fence(__ATOMIC_RELEASE, "agent");
            asm volatile("s_waitcnt vmcnt(0)" ::: "memory");
            const unsigned og = xb_add(&bar[XB_TOP], 1u);
            const unsigned tg = og / nx;
            if (og + 1u == (tg + 1u) * nx) {
#pragma unroll
                for (unsigned j = 0; j < 16; ++j) xb_add(&bar[XB_XGEN(j)], 1u);
                __builtin_amdgcn_fence(__ATOMIC_ACQUIRE, "agent");
            } else { __builtin_amdgcn_fence(__ATOMIC_ACQUIRE, "agent");
                   XB_SPIN(xb_ld(&bar[XB_XGEN(bx)]) == gen, bar); }
            asm volatile("s_waitcnt vmcnt(0)" ::: "memory");
        } else {
            __builtin_amdgcn_fence(__ATOMIC_ACQUIRE, "agent");
            XB_SPIN(xb_ld(&bar[XB_XGEN(bx)]) == gen, bar);
            asm volatile("s_waitcnt vmcnt(0)" ::: "memory");
        }
    }
    __syncthreads();
}
DI void epost_row(bf16_t* raw, int row, int j, float* out, const float* qng, const float* kng, bf16_t* KAd, bf16_t* KBd, bf16_t* VAd, bf16_t* VBd, const float* tab, int lane) {
    int b, t, T, v; row_info(row, b, t, T, v); const bool dec = row >= NCTX; const int pr = t >> 6, pc = t & 63;
    bf16_t* rp = raw + (size_t)row * EVEN_IN;
    u32x4 wall[9];
#pragma unroll
    for (int it = 0; it < 9; ++it) wall[it] = (it < 2 || it == 6 || it == 7) ? (u32x4){0u, 0u, 0u, 0u} : *(const u32x4*)(rp + (it * 64 + lane) * 8);
#pragma unroll
    for (int it = 0; it < 9; ++it) {
        const int c0 = (it * 64 + lane) * 8;
        if (it < 2 || it == 6 || it == 7) continue;
        const u32x4 w = wall[it]; float f[8]; unpack8(w, f);
        if (it < 2) {
            rope_chunk<16>(f, (c0 >> 3) & 7, tab, pr, pc); *(u32x4*)(rp + c0) = pack8(f);
        } else if (it < 4) {
            const int cc = c0 - 1024, h = cc >> 7, c2 = (cc >> 6) & 1, d = cc & 63;
            if (!dec) { float* o = out + O_DAK + ((((size_t)(b * 2 + j) * 8 + h) * 2 + c2) * 256 + t) * 64 + d;
                *(f32x4*)o = (f32x4){f[0], f[1], f[2], f[3]}; *(f32x4*)(o + 4) = (f32x4){f[4], f[5], f[6], f[7]}; }
            else { rope_chunk<16>(f, (c0 >> 3) & 7, tab, pr, pc); *(u32x4*)(KAd + ((size_t)(b * 1280 + 256 + t)) * 1024 + cc) = pack8(f); }
        } else if (it < 6) {
            const int cc = c0 - 2048, h = cc >> 7, d = cc & 127;
            if (!dec) { float* o = out + O_DAV + (((size_t)(b * 2 + j) * 8 + h) * 256 + t) * 128 + d;
                *(f32x4*)o = (f32x4){f[0], f[1], f[2], f[3]}; *(f32x4*)(o + 4) = (f32x4){f[4], f[5], f[6], f[7]}; }
            else *(u32x4*)(VAd + ((size_t)(b * 1280 + 256 + t)) * 1024 + cc) = w;
        } else if (it < 8) {
            const int d = c0 & 127; float ss = 0.f;
#pragma unroll
            for (int e = 0; e < 8; ++e) ss += f[e] * f[e];
            ss = grp16_sum(ss); const float rstd = frsq(ss * (1.0f / 128.0f) + EPS);
#pragma unroll
            for (int e = 0; e < 8; ++e) f[e] = f[e] * rstd * qng[d + e];
            if (dec) rope_chunk<32>(f, (c0 >> 3) & 15, tab, pr, pc);
            *(u32x4*)(rp + c0) = pack8(f);
        } else {
            const bool iskb = lane < 32; const int cc = iskb ? c0 - 4096 : c0 - 4352, g = cc >> 7, d = cc & 127;
            float ss = 0.f;
#pragma unroll
            for (int e = 0; e < 8; ++e) ss += f[e] * f[e];
            ss = grp16_sum(ss); const float rstd = frsq(ss * (1.0f / 128.0f) + EPS);
            float fk[8];
#pragma unroll
            for (int e = 0; e < 8; ++e) fk[e] = f[e] * rstd * kng[d + e];
            if (dec) rope_chunk<32>(fk, (c0 >> 3) & 15, tab, pr, pc);
            if (iskb) {
                if (!dec) { *(u32x4*)(rp + c0) = pack8(fk); float* o = out + O_GQK + (((size_t)(b * 2 + j) * 2 + g) * 256 + t) * 128 + d;
                    *(f32x4*)o = (f32x4){fk[0], fk[1], fk[2], fk[3]}; *(f32x4*)(o + 4) = (f32x4){fk[4], fk[5], fk[6], fk[7]}; }
                else *(u32x4*)(KBd + ((size_t)(b * 1280 + 256 + t)) * 256 + cc) = pack8(fk);
            } else if (!dec) { float* o = out + O_GQV + (((size_t)(b * 2 + j) * 2 + g) * 256 + t) * 128 + d;
                *(f32x4*)o = (f32x4){f[0], f[1], f[2], f[3]}; *(f32x4*)(o + 4) = (f32x4){f[4], f[5], f[6], f[7]}; }
            else *(u32x4*)(VBd + ((size_t)(b * 1280 + 256 + t)) * 256 + cc) = w;
        }
    }
}
DI void epost_cache(int item, int j, const float* cdak, const float* cdav, const float* cgqk, const float* cgqv, bf16_t* KAd, bf16_t* KBd, bf16_t* VAd, bf16_t* VBd, int lane) {
    const int b = item >> 8, s = item & 255;
#pragma unroll
    for (int it = 0; it < 2; ++it) { const int col = (it * 64 + lane) * 8, h = col >> 7, c2 = (col >> 6) & 1, d = col & 63;
        const float* src = cdak + ((((size_t)(b * 2 + j) * 8 + h) * 2 + c2) * 256 + s) * 64 + d;
        const f32x4 a = *(const f32x4*)src, bb = *(const f32x4*)(src + 4); u32x4 w; w.x = pk2(a.x, a.y); w.y = pk2(a.z, a.w); w.z = pk2(bb.x, bb.y); w.w = pk2(bb.z, bb.w);
        *(u32x4*)(KAd + ((size_t)(b * 1280 + s)) * 1024 + col) = w;
        const float* sv = cdav + (((size_t)(b * 2 + j) * 8 + h) * 256 + s) * 128 + (col & 127);
        const f32x4 va = *(const f32x4*)sv, vb = *(const f32x4*)(sv + 4); u32x4 wv; wv.x = pk2(va.x, va.y); wv.y = pk2(va.z, va.w); wv.z = pk2(vb.x, vb.y); wv.w = pk2(vb.z, vb.w);
        *(u32x4*)(VAd + ((size_t)(b * 1280 + s)) * 1024 + col) = wv; }
    if (lane < 32) { const int col = lane * 8, g = col >> 7, d = col & 127;
        const float* src = cgqk + (((size_t)(b * 2 + j) * 2 + g) * 256 + s) * 128 + d;
        const f32x4 a = *(const f32x4*)src, bb = *(const f32x4*)(src + 4); u32x4 w; w.x = pk2(a.x, a.y); w.y = pk2(a.z, a.w); w.z = pk2(bb.x, bb.y); w.w = pk2(bb.z, bb.w);
        *(u32x4*)(KBd + ((size_t)(b * 1280 + s)) * 256 + col) = w;
        const float* sv = cgqv + (((size_t)(b * 2 + j) * 2 + g) * 256 + s) * 128 + d;
        const f32x4 va = *(const f32x4*)sv, vb = *(const f32x4*)(sv + 4); u32x4 wv; wv.x = pk2(va.x, va.y); wv.y = pk2(va.z, va.w); wv.z = pk2(vb.x, vb.y); wv.w = pk2(vb.z, vb.w);
        *(u32x4*)(VBd + ((size_t)(b * 1280 + s)) * 256 + col) = wv; }
}

template <int NDQ, int NDA>
DI void attn_wg(const bf16_t* Q, int ldq, const bf16_t* K, int ldk, const bf16_t* K2, int ldk2, int nkeys, const bf16_t* V, int ldv, float C, f32x16 (&o)[4], float& l_out, LAS unsigned char* lds, int tid, const float* rtab = nullptr, int rt0 = 0, const float* qgain = nullptr) {
    constexpr int ROWK = NDQ * 32 + 16, KB = 64 * ROWK, VB = 128 * 136, BUF = KB + VB, NKC = NDQ / 4;
    const int lane = tid & 63, wave = __builtin_amdgcn_readfirstlane(tid >> 6), r32 = lane & 31, hi = lane >> 5;
    bf16x8 qr[NDQ];
#pragma unroll
    for (int d0 = 0; d0 < NDQ; ++d0) qr[d0] = *(const bf16x8*)(Q + (size_t)(wave * 32 + r32) * ldq + d0 * 16 + hi * 8);
    if constexpr (NDQ == 8) { if (qgain) {
        float ss = 0.f;
#pragma unroll
        for (int d0 = 0; d0 < 8; ++d0) { float f[8]; unpack8(__builtin_bit_cast(u32x4, qr[d0]), f);
#pragma unroll
            for (int e = 0; e < 8; ++e) ss += f[e] * f[e]; }
        ss = xor32_sum(ss); const float rstd = frsq(ss * (1.0f / 128.0f) + EPS);
        const int t = rt0 + wave * 32 + r32, pr = t >> 6, pc = t & 63;
#pragma unroll
        for (int pp = 0; pp < 2; ++pp)
#pragma unroll
            for (int dd = 0; dd < 2; ++dd) { const int pos = pp ? pc : pr, da = 4 * pp + dd, db = da + 2;
                float x1[8], x2[8]; unpack8(__builtin_bit_cast(u32x4, qr[da]), x1); unpack8(__builtin_bit_cast(u32x4, qr[db]), x2);
                const float* ga = qgain + da * 16 + hi * 8; const float* gb = ga + 32;
#pragma unroll
                for (int e = 0; e < 8; ++e) { x1[e] *= rstd * ga[e]; x2[e] *= rstd * gb[e]; }
                if (rtab) {
#pragma unroll
                    for (int e = 0; e < 8; ++e) { const f32x2 cs = *(const f32x2*)(rtab + (size_t)(pos * 32 + (dd * 2 + hi) * 8 + e) * 2); const float a = x1[e] * cs.x - x2[e] * cs.y, b2 = x1[e] * cs.y + x2[e] * cs.x; x1[e] = a; x2[e] = b2; } }
                qr[da] = __builtin_bit_cast(bf16x8, pack8(x1)); qr[db] = __builtin_bit_cast(bf16x8, pack8(x2));
                __builtin_amdgcn_sched_barrier(0);
            }
    } }
    if constexpr (NDQ == 12 || NDQ == 4) { if (rtab) {
        constexpr int qb0 = (NDQ == 12) ? 8 : 0;
        const int t = rt0 + wave * 32 + r32, pr = t >> 6, pc = t & 63;
#pragma unroll
        for (int pp = 0; pp < 2; ++pp) { const int pos = pp ? pc : pr; float x1[8], x2[8]; unpack8(__builtin_bit_cast(u32x4, qr[qb0 + 2 * pp]), x1); unpack8(__builtin_bit_cast(u32x4, qr[qb0 + 1 + 2 * pp]), x2);
#pragma unroll
            for (int e = 0; e < 8; ++e) { const f32x2 cs = *(const f32x2*)(rtab + (size_t)(pos * 32 + 2 * (hi * 8 + e)) * 2); const float a = x1[e] * cs.x - x2[e] * cs.y, b = x1[e] * cs.y + x2[e] * cs.x; x1[e] = a; x2[e] = b; }
            qr[qb0 + 2 * pp] = __builtin_bit_cast(bf16x8, pack8(x1)); qr[qb0 + 1 + 2 * pp] = __builtin_bit_cast(bf16x8, pack8(x2)); }
    } }
    const bf16_t* kp[NKC]; int kstep[NKC], kd[NKC];
#pragma unroll
    for (int i = 0; i < NKC; ++i) { const int idx = tid + 512 * i, key = idx / (2 * NDQ), ch = idx - key * (2 * NDQ); const bool main = ch < 2 * NDA;
        kp[i] = main ? K + (size_t)key * ldk + ch * 8 : K2 + (size_t)key * ldk2 + (ch - 2 * NDA) * 8; kstep[i] = 64 * (main ? ldk : ldk2); kd[i] = key * ROWK + ch * 16; }
    const bf16_t* vp = V + (size_t)lane * ldv + wave * 16; const int vd = KB + (wave * 16) * 136 + lane * 2; const size_t vstep = (size_t)64 * ldv;
    u32x4 ks[NKC], vs[2];
#define AW_LOAD() do { _Pragma("unroll") for (int i = 0; i < NKC; ++i) { ks[i] = *(const u32x4*)kp[i]; kp[i] += kstep[i]; } vs[0] = *(const u32x4*)vp; vs[1] = *(const u32x4*)(vp + 8); vp += vstep; } while (0)
#define AW_WRITE(b) do { _Pragma("unroll") for (int i = 0; i < NKC; ++i) *(LAS u32x4*)(lds + (b) * BUF + kd[i]) = ks[i]; \
        _Pragma("unroll") for (int i = 0; i < 2; ++i) _Pragma("unroll") for (int e = 0; e < 8; ++e) { const unsigned ww = vs[i][e >> 1]; \
            *(LAS unsigned short*)(lds + (b) * BUF + vd + (8 * i + e) * 136) = (unsigned short)((e & 1) ? (ww >> 16) : (ww & 0xffffu)); } } while (0)
#pragma unroll
    for (int d0 = 0; d0 < 4; ++d0)
#pragma unroll
        for (int r = 0; r < 16; ++r) o[d0][r] = 0.f;
    float m = -1e30f, l = 0.f;
    const int NT = nkeys >> 6;
    AW_LOAD(); AW_WRITE(0); __syncthreads();
    const int koff = r32 * ROWK + hi * 16, voff = KB + r32 * 136 + hi * 8;
    for (int t = 0; t < NT; ++t) {
        const int b = t & 1;
        if (t + 1 < NT) AW_LOAD();
        const LAS unsigned char* kb = lds + b * BUF + koff; const LAS unsigned char* vb = lds + b * BUF + voff;
        f32x16 p0, p1;
#pragma unroll
        for (int r = 0; r < 16; ++r) { p0[r] = 0.f; p1[r] = 0.f; }
#pragma unroll
        for (int d0 = 0; d0 < NDQ; ++d0) { const bf16x8 a0 = *(const LAS bf16x8*)(kb + d0 * 32), a1 = *(const LAS bf16x8*)(kb + 32 * ROWK + d0 * 32);
            p0 = MFMA32(a0, qr[d0], p0); p1 = MFMA32(a1, qr[d0], p1); }
        float tm = fmaxf(p0[0], p1[0]);
#pragma unroll
        for (int r = 1; r < 16; ++r) tm = fmaxf(tm, fmaxf(p0[r], p1[r]));
        tm = xor32_max(tm);
        const float mn = fmaxf(m, tm), alpha = __builtin_amdgcn_exp2f((m - mn) * C), mC = mn * C; m = mn;
        float ps = 0.f;
#pragma unroll
        for (int r = 0; r < 16; ++r) { p0[r] = __builtin_amdgcn_exp2f(p0[r] * C - mC); p1[r] = __builtin_amdgcn_exp2f(p1[r] * C - mC); ps += p0[r] + p1[r]; }
        l = l * alpha + ps;
        if (!__all(alpha == 1.0f)) {
#pragma unroll
            for (int d0 = 0; d0 < 4; ++d0)
#pragma unroll
                for (int r = 0; r < 16; ++r) o[d0][r] *= alpha;
        }
        const bf16x8 pb00 = pack_step(p0, 0), pb01 = pack_step(p0, 1), pb10 = pack_step(p1, 0), pb11 = pack_step(p1, 1);
#pragma unroll
        for (int d0 = 0; d0 < 4; ++d0) { const LAS unsigned char* v0 = vb + d0 * 32 * 136;
            o[d0] = MFMA32(cat4(*(const LAS s16x4*)(v0), *(const LAS s16x4*)(v0 + 16)), pb00, o[d0]);
            o[d0] = MFMA32(cat4(*(const LAS s16x4*)(v0 + 32), *(const LAS s16x4*)(v0 + 48)), pb01, o[d0]);
            o[d0] = MFMA32(cat4(*(const LAS s16x4*)(v0 + 64), *(const LAS s16x4*)(v0 + 80)), pb10, o[d0]);
            o[d0] = MFMA32(cat4(*(const LAS s16x4*)(v0 + 96), *(const LAS s16x4*)(v0 + 112)), pb11, o[d0]); }
        if (t + 1 < NT) AW_WRITE(b ^ 1);
        __syncthreads();
    }
#undef AW_LOAD
#undef AW_WRITE
    l_out = xor32_sum(l);
}
DI void store_ot(const f32x16 (&o)[4], float inv, bf16_t* dst, int ld, int lane) {
    const int r32 = lane & 31, hi = lane >> 5; bf16_t* p = dst + (size_t)r32 * ld + 4 * hi;
#pragma unroll
    for (int d0 = 0; d0 < 4; ++d0)
#pragma unroll
        for (int g = 0; g < 4; ++g) { u32x2 w; w.x = pk2(o[d0][4 * g] * inv, o[d0][4 * g + 1] * inv); w.y = pk2(o[d0][4 * g + 2] * inv, o[d0][4 * g + 3] * inv); *(u32x2*)(p + d0 * 32 + 8 * g) = w; }
}
constexpr float C_DA = 0.125f * 1.4426950408889634f, C_GQ = 0.08838834764831845f * 1.4426950408889634f, C_MLA = 0.07216878364870323f * 1.4426950408889634f;
DI void da_unit(int idx, int j, const bf16_t* raw, const bf16_t* KAd, const bf16_t* VAd, const float* dalam, const float* daln, float lam_init, bf16_t* mix, const float* tab, LAS unsigned char* lds, int tid) {
    const int lane = tid & 63, wave = __builtin_amdgcn_readfirstlane(tid >> 6), hi = lane >> 5;
    const bool dec = idx < 64; int b, hh, qb; if (dec) { b = idx >> 5; hh = (idx >> 2) & 7; qb = idx & 3; } else { const int i2 = idx - 64; b = i2 >> 3; hh = i2 & 7; qb = 0; }
    const int row0 = dec ? NCTX + b * 1024 + qb * 256 : b * 256, nkeys = dec ? 1280 : 256;
    const bf16_t* Q = raw + (size_t)row0 * EVEN_IN + hh * 128;
    const bf16_t* K = dec ? KAd + (size_t)(b * 1280) * 1024 + hh * 128 : raw + (size_t)(b * 256) * EVEN_IN + 1024 + hh * 128; const int ldk = dec ? 1024 : EVEN_IN;
    const bf16_t* Vt = dec ? VAd + (size_t)(b * 1280) * 1024 + hh * 128 : raw + (size_t)(b * 256) * EVEN_IN + 2048 + hh * 128; const int ldvt = dec ? 1024 : EVEN_IN;
    f32x16 o[4]; float l;
    LAS u32x4* park = (LAS u32x4*)(lds + 53248 + wave * 8192) + lane;
#pragma unroll 1
    for (int c = 0; c < 2; ++c) {
        attn_wg<4, 4>(Q + c * 64, EVEN_IN, K + c * 64, ldk, K + c * 64, ldk, nkeys, Vt, ldvt, C_DA, o, l, lds, tid, dec ? tab : (const float*)nullptr, qb * 256);
        if (c == 0) { const float i0 = 1.0f / l;
#pragma unroll
            for (int d0 = 0; d0 < 4; ++d0)
#pragma unroll
                for (int hf = 0; hf < 2; ++hf) { u32x4 w; w.x = pk2(o[d0][8 * hf] * i0, o[d0][8 * hf + 1] * i0); w.y = pk2(o[d0][8 * hf + 2] * i0, o[d0][8 * hf + 3] * i0);
                    w.z = pk2(o[d0][8 * hf + 4] * i0, o[d0][8 * hf + 5] * i0); w.w = pk2(o[d0][8 * hf + 6] * i0, o[d0][8 * hf + 7] * i0); park[(d0 * 2 + hf) * 64] = w; } }
    }
    const float* lm = dalam + j * 256;
    const float s1 = wave_sum(lm[lane] * lm[64 + lane]), s2 = wave_sum(lm[128 + lane] * lm[192 + lane]);
    const float lam = fexp(s1) - fexp(s2) + lam_init;
    const float i1 = lam / l; float ss = 0.f;
    f32x16 o0[4];
#pragma unroll
    for (int d0 = 0; d0 < 4; ++d0)
#pragma unroll
        for (int hf = 0; hf < 2; ++hf) { const u32x4 w = park[(d0 * 2 + hf) * 64]; float f[8]; unpack8(w, f);
#pragma unroll
            for (int e = 0; e < 8; ++e) { const float v = f[e] - o[d0][8 * hf + e] * i1; o0[d0][8 * hf + e] = v; ss += v * v; } }
    ss = xor32_sum(ss);
    const float rstd = frsq(ss * (1.0f / 128.0f) + EPS) * (1.0f - lam_init);
    const float* gg = daln + j * 128 + 4 * hi;
#pragma unroll
    for (int d0 = 0; d0 < 4; ++d0)
#pragma unroll
        for (int g = 0; g < 4; ++g) { const f32x4 g4 = *(const f32x4*)(gg + d0 * 32 + 8 * g);
            o0[d0][4 * g] *= g4.x; o0[d0][4 * g + 1] *= g4.y; o0[d0][4 * g + 2] *= g4.z; o0[d0][4 * g + 3] *= g4.w; }
    store_ot(o0, rstd, mix + (size_t)(row0 + wave * 32) * DM + hh * 128, DM, lane);
}
DI void gqa_unit(int idx, const bf16_t* raw, const bf16_t* KBd, const bf16_t* VBd, bf16_t* mix, const float* qgain, const float* tab, LAS unsigned char* lds, int tid) {
    const int lane = tid & 63, wave = __builtin_amdgcn_readfirstlane(tid >> 6);
    const bool dec = idx < 64; int b, hh, qb; if (dec) { b = idx >> 5; hh = (idx >> 2) & 7; qb = idx & 3; } else { const int i2 = idx - 64; b = i2 >> 3; hh = i2 & 7; qb = 0; }
    const int row0 = dec ? NCTX + b * 1024 + qb * 256 : b * 256, nkeys = dec ? 1280 : 256, g = hh >> 2;
    const bf16_t* Q = raw + (size_t)row0 * EVEN_IN + 3072 + hh * 128;
    const bf16_t* K = dec ? KBd + (size_t)(b * 1280) * 256 + g * 128 : raw + (size_t)(b * 256) * EVEN_IN + 4096 + g * 128; const int ldk = dec ? 256 : EVEN_IN;
    const bf16_t* Vt = dec ? VBd + (size_t)(b * 1280) * 256 + g * 128 : raw + (size_t)(b * 256) * EVEN_IN + 4352 + g * 128; const int ldvt = dec ? 256 : EVEN_IN;
    f32x16 o[4]; float l;
    attn_wg<8, 8>(Q, EVEN_IN, K, ldk, K, ldk, nkeys, Vt, ldvt, C_GQ, o, l, lds, tid, dec ? tab : (const float*)nullptr, qb * 256, qgain);
    store_ot(o, 1.0f / l, mix + (size_t)(row0 + wave * 32) * DM + 1024 + hh * 128, DM, lane);
}
DI int mkv_row(int row) { return row < NCTX ? row : NCTX + ((row - NCTX) >> 10) * 1280 + 256 + ((row - NCTX) & 1023); }
DI void opost_row(const bf16_t* raw, const bf16_t* P2, int row, int j, float* out, const float* gate_b, const float* qng, const float* kvng, float* G, bf16_t* QD, bf16_t* CKV, bf16_t* KPE, const float* tab, int lane) {
    int b, t, T, v; row_info(row, b, t, T, v); const bool dec = row >= NCTX; const int pr = t >> 6, pc = t & 63, mrow = mkv_row(row);
    const bf16_t* rp = raw + (size_t)row * ODD_INP;
    const bf16_t* pp = P2 + (size_t)row * 128; unsigned short gq[4]; u32x4 pe4[4];
#pragma unroll
    for (int k = 0; k < 4; ++k) { gq[k] = pp[(size_t)k * MTOK * 128 + 64 + (lane & 31)]; pe4[k] = *(const u32x4*)(pp + (size_t)k * MTOK * 128 + (lane & 7) * 8); }
    const u32x4 wq = *(const u32x4*)(rp + 4096 + lane * 8), wkv = *(const u32x4*)(rp + 4608 + (lane & 31) * 8);
    const float graw = (bf2f(gq[0]) + bf2f(gq[1])) + (bf2f(gq[2]) + bf2f(gq[3]));
    if (lane < 32) { float val = graw + gate_b[j * 32 + lane]; const int k = lane >> 3, hh = lane & 7; if (k & 1) val = logsigmoidf_(val); G[((size_t)k * MTOK + row) * 8 + hh] = val; }
    {
        const u32x4 w = wq; float f[8]; unpack8(w, f); float ss = 0.f;
#pragma unroll
        for (int e = 0; e < 8; ++e) ss += f[e] * f[e];
        ss = wave_sum(ss); const float rstd = frsq(ss * (1.0f / 512.0f) + EPS);
#pragma unroll
        for (int e = 0; e < 8; ++e) f[e] = f[e] * rstd * qng[j * 512 + lane * 8 + e];
        *(u32x4*)(QD + (size_t)row * 512 + lane * 8) = pack8(f);
    }
    {
        float f[8]; float ss = 0.f;
        if (lane < 32) { const u32x4 w = wkv; unpack8(w, f);
#pragma unroll
            for (int e = 0; e < 8; ++e) ss += f[e] * f[e]; }
        else {
#pragma unroll
            for (int e = 0; e < 8; ++e) f[e] = 0.f; }
        ss = wave_sum(ss); const float rstd = frsq(ss * (1.0f / 256.0f) + EPS);
        if (lane < 32) {
#pragma unroll
            for (int e = 0; e < 8; ++e) f[e] = f[e] * rstd * kvng[j * 256 + lane * 8 + e];
            *(u32x4*)(CKV + (size_t)mrow * 256 + lane * 8) = pack8(f);
            if (!dec) { float* o = out + O_CKV + ((size_t)(b * 2 + j) * 256 + t) * 256 + lane * 8; *(f32x4*)o = (f32x4){f[0], f[1], f[2], f[3]}; *(f32x4*)(o + 4) = (f32x4){f[4], f[5], f[6], f[7]}; }
        }
    }
    {
        float f[8];
        if (lane < 8) { float a0[8], a1[8], a2[8], a3[8]; unpack8(pe4[0], a0); unpack8(pe4[1], a1); unpack8(pe4[2], a2); unpack8(pe4[3], a3);
#pragma unroll
            for (int e = 0; e < 8; ++e) f[e] = (a0[e] + a1[e]) + (a2[e] + a3[e]); }
        else {
#pragma unroll
            for (int e = 0; e < 8; ++e) f[e] = 0.f; }
        if (!dec) { if (lane < 8) { float* o = out + O_KPE + ((size_t)(b * 2 + j) * 256 + t) * 64 + lane * 8; *(f32x4*)o = (f32x4){f[0], f[1], f[2], f[3]}; *(f32x4*)(o + 4) = (f32x4){f[4], f[5], f[6], f[7]}; } }
        else rope_chunk<16>(f, lane & 7, tab, pr, pc);
        if (lane < 8) *(u32x4*)(KPE + (size_t)mrow * 64 + lane * 8) = pack8(f);
    }
}
DI void opost_conv(const bf16_t* raw, int item, int j, const float* cw, const float* cb, bf16_t* QM, bf16_t* KM, int lane) {
    const int rb = item >> 2, cg = item & 3, row0 = rb * 8, c0 = (cg * 64 + lane) * 8;
    int b, t0, T, v; row_info(row0, b, t0, T, v);
    const bf16_t* r0 = raw + (size_t)row0 * ODD_INP + c0; const u32x4 z = {0u, 0u, 0u, 0u};
    u32x4 xq[10];
#pragma unroll
    for (int i = 0; i < 10; ++i) { const int t = t0 + i - 1; const bool ok = (t >= 0) && (t < T); xq[i] = ok ? *(const u32x4*)(r0 + (long)(i - 1) * ODD_INP) : z; }
    const float* w0 = cw + (size_t)j * 3 * 2048 + c0; const float* bb = cb + (size_t)j * 2048 + c0;
    f32x4 wk[3][2], bk[2];
#pragma unroll
    for (int e = 0; e < 2; ++e) { bk[e] = *(const f32x4*)(bb + 4 * e);
#pragma unroll
        for (int k = 0; k < 3; ++k) wk[k][e] = *(const f32x4*)(w0 + (size_t)k * 2048 + 4 * e); }
    const bool isq = cg < 2; const float osc = isq ? 0.08838834764831845f : 1.0f;
    u32x4 ov[8];
#pragma unroll
    for (int i = 0; i < 8; ++i) { float a[8], bq[8], c[8], y[8]; unpack8(xq[i], a); unpack8(xq[i + 1], bq); unpack8(xq[i + 2], c);
#pragma unroll
        for (int e = 0; e < 2; ++e)
#pragma unroll
            for (int q = 0; q < 4; ++q) { const int x = 4 * e + q; const float s = bk[e][q] + wk[0][e][q] * a[x] + wk[1][e][q] * bq[x] + wk[2][e][q] * c[x]; y[x] = siluf_(s) * osc; }
        ov[i] = pack8(y); }
    bf16_t* dst = (isq ? QM : KM) + (size_t)row0 * 1024 + (isq ? c0 : c0 - 1024);
#pragma unroll
    for (int i = 0; i < 8; ++i) *(u32x4*)(dst + (size_t)i * 1024) = ov[i];
}
DI void opost_cache(int item, int j, const float* cckv, const float* ckpe, bf16_t* CKV, bf16_t* KPE, int lane) {
    const int b = item >> 8, s = item & 255; const size_t mrow = NCTX + b * 1280 + s;
    if (lane < 32) { const float* src = cckv + ((size_t)(b * 2 + j) * 256 + s) * 256 + lane * 8; const f32x4 a = *(const f32x4*)src, bb = *(const f32x4*)(src + 4);
        u32x4 w; w.x = pk2(a.x, a.y); w.y = pk2(a.z, a.w); w.z = pk2(bb.x, bb.y); w.w = pk2(bb.z, bb.w); *(u32x4*)(CKV + mrow * 256 + lane * 8) = w; }
    else if (lane < 40) { const int l8 = lane - 32; const float* src = ckpe + ((size_t)(b * 2 + j) * 256 + s) * 64 + l8 * 8; const f32x4 a = *(const f32x4*)src, bb = *(const f32x4*)(src + 4);
        u32x4 w; w.x = pk2(a.x, a.y); w.y = pk2(a.z, a.w); w.z = pk2(bb.x, bb.y); w.w = pk2(bb.z, bb.w); *(u32x4*)(KPE + mrow * 64 + l8 * 8) = w; }
}
DI void lds_barrier() { asm volatile("s_waitcnt lgkmcnt(0)" ::: "memory"); __builtin_amdgcn_s_barrier(); asm volatile("" ::: "memory"); }
constexpr int ML_Q = 0, ML_K = 16896, ML_KT = 33792, ML_VT = 52224, ML_DIR = 69632;
DI void mlstm_wg(int unit, int dirsel, int j, const bf16_t* QM, const bf16_t* KM, const bf16_t* RAWV, const float* G, const float* stC, const float* stN, const float* stM,
                 bf16_t* HF, float* out, const float* mlng, bf16_t* mix, LAS unsigned char* lds, LAS float* scbase, int tid) {
    const int lane = tid & 63, wave = __builtin_amdgcn_readfirstlane(tid >> 6), r32 = lane & 31, hi = lane >> 5, vb = wave & 3, tl = tid & 255;
    const int dir = (dirsel < 0) ? (wave >> 2) : dirsel; const bool active = (dirsel < 0) || (wave < 4);
    const bool isdec = unit < 16; const int u2 = isdec ? unit : unit - 16, b = u2 >> 3, h = u2 & 7;
    const int T = isdec ? 1024 : 256, nc = T >> 6, row0 = isdec ? NCTX + b * 1024 : b * 256;
    LAS unsigned char* Ld = lds + ((dirsel < 0) ? dir : 0) * ML_DIR;
    LAS float* sc = scbase + wave * 384; LAS float* sU = sc; LAS float* sM = sc + 64; LAS float* sB = sc + 128; LAS float* sW = sc + 192; LAS float* sN = sc + 256;
    f32x16 C[4]; float m_prev = 0.f;
    const size_t sidx = (((size_t)(b * 2 + j) * 2 + dir) * 8 + h);
#pragma unroll
    for (int dkb = 0; dkb < 4; ++dkb)
#pragma unroll
        for (int r = 0; r < 16; ++r) C[dkb][r] = 0.f;
    if (!active) { } else if (isdec) {
        const float* cp = stC + sidx * 16384 + vb * 32 + r32;
#pragma unroll
        for (int dkb = 0; dkb < 4; ++dkb)
#pragma unroll
            for (int r = 0; r < 16; ++r) C[dkb][r] = cp[(size_t)(dkb * 32 + crow(r, hi)) * 128];
        sN[lane] = stN[sidx * 128 + lane]; sN[64 + lane] = stN[sidx * 128 + 64 + lane]; m_prev = stM[sidx];
    } else {
#pragma unroll
        for (int dkb = 0; dkb < 4; ++dkb)
#pragma unroll
            for (int r = 0; r < 16; ++r) C[dkb][r] = 0.f;
        sN[lane] = 0.f; sN[64 + lane] = 0.f; m_prev = 0.f;
    }
    const float* GIp = G + ((size_t)(2 * dir) * MTOK) * 8 + h; const float* GFp = G + ((size_t)(2 * dir + 1) * MTOK) * 8 + h;
    const int mj = dir ? 63 - lane : lane;
    (void)tl;
    const bool lmode = dirsel >= 0;
    auto stage_all = [&](LAS unsigned char* Lb, int tk0) {
        u32x4 a[4], c[4], vv[4];
        const size_t roff = (size_t)(tk0 + lane) * 1024 + h * 128 + vb * 16, voff = (size_t)(tk0 + lane) * ODD_INP + 2048 + h * 128 + vb * 16;
#pragma unroll
        for (int i = 0; i < 4; ++i) { a[i] = *(const u32x4*)(QM + roff + 8 * (i & 1) + 64 * (i >> 1)); c[i] = *(const u32x4*)(KM + roff + 8 * (i & 1) + 64 * (i >> 1)); vv[i] = *(const u32x4*)(RAWV + voff + 8 * (i & 1) + 64 * (i >> 1)); }
#pragma unroll
        for (int i = 0; i < 4; ++i) { const int c16 = 2 * vb + (i & 1) + 8 * (i >> 1);
            LAS u32x2* dq = (LAS u32x2*)(Lb + ML_Q + lane * 264 + c16 * 16); dq[0] = (u32x2){a[i].x, a[i].y}; dq[1] = (u32x2){a[i].z, a[i].w};
            LAS u32x2* dk = (LAS u32x2*)(Lb + ML_K + lane * 264 + c16 * 16); dk[0] = (u32x2){c[i].x, c[i].y}; dk[1] = (u32x2){c[i].z, c[i].w};
#pragma unroll
            for (int e = 0; e < 8; ++e) { const unsigned ww = c[i][e >> 1]; *(LAS unsigned short*)(Lb + ML_KT + (c16 * 8 + e) * 144 + lane * 2) = (unsigned short)((e & 1) ? (ww >> 16) : (ww & 0xffffu)); }
#pragma unroll
            for (int e = 0; e < 8; ++e) { const unsigned ww = vv[i][e >> 1]; *(LAS unsigned short*)(Lb + ML_VT + (c16 * 8 + e) * 136 + lane * 2) = (unsigned short)((e & 1) ? (ww >> 16) : (ww & 0xffffu)); } }
    };
    float li_n = 0.f, lf_n = 0.f;
    if (lmode) { const int tk0 = row0 + (dir ? nc - 1 : 0) * 64;
        if (wave >= 4) stage_all(lds, tk0); else { li_n = GIp[(size_t)(tk0 + mj) * 8]; lf_n = GFp[(size_t)(tk0 + mj) * 8]; } }
#pragma unroll 1
    for (int ci = 0; ci < nc; ++ci) {
        const int chunk = dir ? nc - 1 - ci : ci, tok0 = row0 + chunk * 64;
        lds_barrier();
        LAS unsigned char* Lc = Ld;
        if (lmode) {
            const int tk1 = row0 + (dir ? nc - 2 - ci : ci + 1) * 64;
            if (wave >= 4) { if (ci + 1 < nc) stage_all(lds + ((ci + 1) & 1) * ML_DIR, tk1); continue; }
            const float li = li_n, lf = lf_n;
            if (ci + 1 < nc) { li_n = GIp[(size_t)(tk1 + mj) * 8]; lf_n = GFp[(size_t)(tk1 + mj) * 8]; }
            {
                const float bc = wave_scan_sum(lf);
                const float u = li - bc; const float pmx = wave_scan_max(u);
                const float Mv = fmaxf(m_prev, pmx);
                const float Mend_ = __uint_as_float((unsigned)__builtin_amdgcn_readlane((int)__float_as_uint(Mv), 63));
                sU[mj] = u; sM[mj] = Mv; sB[mj] = bc; sW[mj] = fexp(u - Mend_);
            }
            Lc = lds + (ci & 1) * ML_DIR;
        } else {
        {
            u32x4 a[4], c[4], vv[4];
            const size_t voff = (size_t)(tok0 + lane) * ODD_INP + 2048 + h * 128 + vb * 16;
            const size_t roff = (size_t)(tok0 + lane) * 1024 + h * 128 + vb * 16;
#pragma unroll
            for (int i = 0; i < 4; ++i) { a[i] = *(const u32x4*)(QM + roff + 8 * (i & 1) + 64 * (i >> 1)); c[i] = *(const u32x4*)(KM + roff + 8 * (i & 1) + 64 * (i >> 1)); vv[i] = *(const u32x4*)(RAWV + voff + 8 * (i & 1) + 64 * (i >> 1)); }
            const float li = GIp[(size_t)(tok0 + mj) * 8], lf = GFp[(size_t)(tok0 + mj) * 8];
#pragma unroll
            for (int i = 0; i < 4; ++i) { const int c16 = 2 * vb + (i & 1) + 8 * (i >> 1);
                LAS u32x2* dq = (LAS u32x2*)(Ld + ML_Q + lane * 264 + c16 * 16); dq[0] = (u32x2){a[i].x, a[i].y}; dq[1] = (u32x2){a[i].z, a[i].w};
                LAS u32x2* dk = (LAS u32x2*)(Ld + ML_K + lane * 264 + c16 * 16); dk[0] = (u32x2){c[i].x, c[i].y}; dk[1] = (u32x2){c[i].z, c[i].w};
#pragma unroll
                for (int e = 0; e < 8; ++e) { const unsigned ww = c[i][e >> 1]; *(LAS unsigned short*)(Ld + ML_KT + (c16 * 8 + e) * 144 + lane * 2) = (unsigned short)((e & 1) ? (ww >> 16) : (ww & 0xffffu)); } }
            __builtin_amdgcn_sched_barrier(0);
            {
                const float bc = wave_scan_sum(lf);
                const float u = li - bc; const float pmx = wave_scan_max(u);
                const float Mv = fmaxf(m_prev, pmx);
                const float Mend_ = __uint_as_float((unsigned)__builtin_amdgcn_readlane((int)__float_as_uint(Mv), 63));
                sU[mj] = u; sM[mj] = Mv; sB[mj] = bc; sW[mj] = fexp(u - Mend_);
            }
#pragma unroll
            for (int i = 0; i < 4; ++i) { const int c16 = 2 * vb + (i & 1) + 8 * (i >> 1);
#pragma unroll
                for (int e = 0; e < 8; ++e) { const unsigned ww = vv[i][e >> 1]; *(LAS unsigned short*)(Ld + ML_VT + (c16 * 8 + e) * 136 + lane * 2) = (unsigned short)((e & 1) ? (ww >> 16) : (ww & 0xffffu)); } }
            __builtin_amdgcn_sched_barrier(0);
        }
        lds_barrier();
        }
        const float Mend = sM[dir ? 0 : 63], bend = sB[dir ? 0 : 63];
        const float decay = fexp(m_prev - Mend);
        const LAS unsigned char* vrow = Lc + ML_VT + (vb * 32 + r32) * 136;
#pragma unroll 1
        for (int tb = 0; tb < 2; ++tb) {
            const int t_m = tb * 32 + r32;
            const LAS unsigned char* qp = Lc + ML_Q + t_m * 264 + hi * 8;
            const LAS unsigned char* kp0 = Lc + ML_K + r32 * 264 + hi * 8; const LAS unsigned char* kp1 = kp0 + 32 * 264;
            const float Mt = sM[t_m], Bt = sB[t_m], a_t = fexp(m_prev - Mt); const int tq = t_m - 4 * hi;
            f32x16 st0, st1, N; float qn = 0.f;
#pragma unroll
            for (int r = 0; r < 16; ++r) { st0[r] = 0.f; st1[r] = 0.f; N[r] = 0.f; }
#pragma unroll 2
            for (int d0 = 0; d0 < 8; ++d0) {
                const bf16x8 qf = cat4(*(const LAS s16x4*)(qp + d0 * 32), *(const LAS s16x4*)(qp + d0 * 32 + 16));
                const bf16x8 k0 = cat4(*(const LAS s16x4*)(kp0 + d0 * 32), *(const LAS s16x4*)(kp0 + d0 * 32 + 16));
                const bf16x8 k1 = cat4(*(const LAS s16x4*)(kp1 + d0 * 32), *(const LAS s16x4*)(kp1 + d0 * 32 + 16));
                st0 = MFMA32(k0, qf, st0); st1 = MFMA32(k1, qf, st1);
                const f32x4 n0 = *(const LAS f32x4*)(sN + 16 * d0 + 4 * hi), n1 = *(const LAS f32x4*)(sN + 16 * d0 + 8 + 4 * hi);
                qn += bf2f((unsigned short)qf[0]) * n0.x + bf2f((unsigned short)qf[1]) * n0.y + bf2f((unsigned short)qf[2]) * n0.z + bf2f((unsigned short)qf[3]) * n0.w
                    + bf2f((unsigned short)qf[4]) * n1.x + bf2f((unsigned short)qf[5]) * n1.y + bf2f((unsigned short)qf[6]) * n1.z + bf2f((unsigned short)qf[7]) * n1.w;
            }
            __builtin_amdgcn_sched_barrier(0);
#pragma unroll
            for (int d0 = 0; d0 < 8; ++d0) {
                const bf16x8 qf = cat4(*(const LAS s16x4*)(qp + d0 * 32), *(const LAS s16x4*)(qp + d0 * 32 + 16));
                N = MFMA32(pack_step(C[d0 >> 1], d0 & 1), qf, N);
            }
            __builtin_amdgcn_sched_barrier(0);
            float rs = 0.f;
#pragma unroll
            for (int g = 0; g < 4; ++g) {
                const f32x4 u0 = *(const LAS f32x4*)(sU + 8 * g + 4 * hi), u1 = *(const LAS f32x4*)(sU + 32 + 8 * g + 4 * hi);
#pragma unroll
                for (int i = 0; i < 4; ++i) { const int r = 4 * g + i, c0 = 8 * g + i, c1 = 32 + c0;
                    const bool ok0 = dir ? (c0 >= tq) : (c0 <= tq), ok1 = dir ? (c1 >= tq) : (c1 <= tq);
                    const float w0 = fexp(fminf(u0[i] - Mt, 0.f)), w1 = fexp(fminf(u1[i] - Mt, 0.f));
                    st0[r] = ok0 ? st0[r] * w0 : 0.f; st1[r] = ok1 ? st1[r] * w1 : 0.f; rs += st0[r] + st1[r]; }
            }
#pragma unroll
            for (int r = 0; r < 16; ++r) N[r] *= a_t;
            const LAS unsigned char* vp = vrow + hi * 8;
            N = MFMA32(cat4(*(const LAS s16x4*)(vp), *(const LAS s16x4*)(vp + 16)), pack_step(st0, 0), N);
            N = MFMA32(cat4(*(const LAS s16x4*)(vp + 32), *(const LAS s16x4*)(vp + 48)), pack_step(st0, 1), N);
            N = MFMA32(cat4(*(const LAS s16x4*)(vp + 64), *(const LAS s16x4*)(vp + 80)), pack_step(st1, 0), N);
            N = MFMA32(cat4(*(const LAS s16x4*)(vp + 96), *(const LAS s16x4*)(vp + 112)), pack_step(st1, 1), N);
            qn = xor32_sum(qn); rs = xor32_sum(rs);
            const float den = rs + a_t * qn, dn = fmaxf(fabsf(den), fexp(-(Bt + Mt))), inv = 1.0f / dn;
            bf16_t* hp = HF + ((size_t)dir * MTOK + tok0 + t_m) * 1024 + h * 128 + vb * 32 + 8 * hi;
#pragma unroll
            for (int g = 0; g < 4; g += 2) {
                const unsigned a0 = pk2(N[4 * g] * inv, N[4 * g + 1] * inv), a1 = pk2(N[4 * g + 2] * inv, N[4 * g + 3] * inv), b0 = pk2(N[4 * g + 4] * inv, N[4 * g + 5] * inv), b1 = pk2(N[4 * g + 6] * inv, N[4 * g + 7] * inv);
                const auto r0 = __builtin_amdgcn_permlane32_swap(a0, b0, false, false), r1 = __builtin_amdgcn_permlane32_swap(a1, b1, false, false);
                *(u32x4*)(hp + 8 * g) = (u32x4){r0[0], r1[0], r0[1], r1[1]}; }
        }
        bf16x8 vw[4];
#pragma unroll
        for (int ks = 0; ks < 4; ++ks) { const LAS unsigned char* v0 = vrow + (16 * ks + 8 * hi) * 2; const u32x2 wa = *(const LAS u32x2*)v0, wb = *(const LAS u32x2*)(v0 + 8);
            float f[8]; f[0] = bf_lo(wa.x); f[1] = bf_hi(wa.x); f[2] = bf_lo(wa.y); f[3] = bf_hi(wa.y); f[4] = bf_lo(wb.x); f[5] = bf_hi(wb.x); f[6] = bf_lo(wb.y); f[7] = bf_hi(wb.y);
            const f32x4 w0 = *(const LAS f32x4*)(sW + 16 * ks + 8 * hi), w1 = *(const LAS f32x4*)(sW + 16 * ks + 8 * hi + 4);
            f[0] *= w0.x; f[1] *= w0.y; f[2] *= w0.z; f[3] *= w0.w; f[4] *= w1.x; f[5] *= w1.y; f[6] *= w1.z; f[7] *= w1.w;
            vw[ks] = __builtin_bit_cast(bf16x8, pack8(f)); }
#pragma unroll
        for (int dkb = 0; dkb < 4; ++dkb) {
#pragma unroll
            for (int r = 0; r < 16; ++r) C[dkb][r] *= decay;
            float na = 0.f; const LAS unsigned char* ktp = Lc + ML_KT + (dkb * 32 + r32) * 144 + hi * 16;
#pragma unroll
            for (int ks = 0; ks < 4; ++ks) { const u32x4 w = *(const LAS u32x4*)(ktp + 32 * ks); C[dkb] = MFMA32(__builtin_bit_cast(bf16x8, w), vw[ks], C[dkb]); float f[8]; unpack8(w, f);
                const f32x4 w0 = *(const LAS f32x4*)(sW + 16 * ks + 8 * hi), w1 = *(const LAS f32x4*)(sW + 16 * ks + 8 * hi + 4);
                na += f[0] * w0.x + f[1] * w0.y + f[2] * w0.z + f[3] * w0.w + f[4] * w1.x + f[5] * w1.y + f[6] * w1.z + f[7] * w1.w; }
            na = xor32_sum(na);
            const float nn = decay * sN[dkb * 32 + r32] + na;
            if (hi == 0) sN[dkb * 32 + r32] = nn;
            __builtin_amdgcn_sched_barrier(0);
        }
        m_prev = bend + Mend;
    }
    if (active && !isdec) {
        float* cp = out + O_MLC + sidx * 16384 + vb * 32 + r32;
#pragma unroll
        for (int dkb = 0; dkb < 4; ++dkb)
#pragma unroll
            for (int r = 0; r < 16; ++r) cp[(size_t)(dkb * 32 + crow(r, hi)) * 128] = C[dkb][r];
        if (vb == 0) { out[O_MLN + sidx * 128 + lane] = sN[lane]; out[O_MLN + sidx * 128 + 64 + lane] = sN[64 + lane]; if (lane == 0) out[O_MLM + sidx] = m_prev; }
    }
    __syncthreads();
    if (!isdec) {
#pragma unroll 1
        for (int i0 = 0; i0 < 8; i0 += 4) {
            u32x4 w0[4], w1[4], ow[4];
#pragma unroll
            for (int i = 0; i < 4; ++i) { const size_t row = row0 + (tid >> 4) + 32 * (i0 + i); const int c0 = h * 128 + (tid & 15) * 8;
                w0[i] = *(const u32x4*)(HF + row * 1024 + c0); w1[i] = *(const u32x4*)(HF + ((size_t)MTOK + row) * 1024 + c0); ow[i] = *(const u32x4*)(RAWV + row * ODD_INP + 3072 + c0); }
#pragma unroll
            for (int i = 0; i < 4; ++i) { const size_t row = row0 + (tid >> 4) + 32 * (i0 + i); const int cl = (tid & 15) * 8;
                float f[8], f1[8], om[8]; unpack8(w0[i], f); unpack8(w1[i], f1); unpack8(ow[i], om); float ss = 0.f;
#pragma unroll
                for (int e = 0; e < 8; ++e) { f[e] += f1[e]; ss += f[e] * f[e]; }
                ss = grp16_sum(ss); const float rstd = frsq(ss * (1.0f / 128.0f) + EPS);
#pragma unroll
                for (int e = 0; e < 8; ++e) f[e] = f[e] * rstd * mlng[cl + e] * sigmoidf_(om[e]);
                *(u32x4*)(mix + row * DM + h * 128 + cl) = pack8(f); }
        }
    }
}
DI void mla_unit(int idx, const bf16_t* CQ, const bf16_t* KV, const bf16_t* KPE, bf16_t* mix, const float* tab, LAS unsigned char* lds, int tid) {
    const int lane = tid & 63, wave = __builtin_amdgcn_readfirstlane(tid >> 6);
    const bool dec = idx < 64; int b, hh, qb; if (dec) { b = idx >> 5; hh = (idx >> 2) & 7; qb = idx & 3; } else { const int i2 = idx - 64; b = i2 >> 3; hh = i2 & 7; qb = 0; }
    const int row0 = dec ? NCTX + b * 1024 + qb * 256 : b * 256, nkeys = dec ? 1280 : 256, krow0 = dec ? NCTX + b * 1280 : b * 256;
    f32x16 o[4]; float l;
    attn_wg<12, 8>(CQ + (size_t)row0 * 1536 + hh * 192, 1536, KV + (size_t)krow0 * 2048 + hh * 256, 2048, KPE + (size_t)krow0 * 64, 64, nkeys, KV + (size_t)krow0 * 2048 + hh * 256 + 128, 2048, C_MLA, o, l, lds, tid, dec ? tab : (const float*)nullptr, qb * 256);
    store_ot(o, 1.0f / l, mix + (size_t)(row0 + wave * 32) * DM + 1024 + hh * 128, DM, lane);
}
DI void opmix_row(const bf16_t* HF, const bf16_t* raw, int row, const float* g, bf16_t* mix, int lane) {
#pragma unroll
    for (int it = 0; it < 2; ++it) {
        const int c0 = (it * 64 + lane) * 8; const bf16_t* h0 = HF + (size_t)row * 1024 + c0; const bf16_t* h1 = h0 + (size_t)MTOK * 1024;
        const u32x4 w0 = *(const u32x4*)h0, w1 = *(const u32x4*)h1; float f[8], f1[8]; unpack8(w0, f); unpack8(w1, f1); float ss = 0.f;
#pragma unroll
        for (int e = 0; e < 8; ++e) f[e] += f1[e];
#pragma unroll
        for (int e = 0; e < 8; ++e) ss += f[e] * f[e];
        ss = grp16_sum(ss); const float rstd = frsq(ss * (1.0f / 128.0f) + EPS);
        const u32x4 ow = *(const u32x4*)(raw + (size_t)row * ODD_INP + 3072 + c0); float om[8]; unpack8(ow, om);
#pragma unroll
        for (int e = 0; e < 8; ++e) f[e] = f[e] * rstd * g[(c0 & 127) + e] * sigmoidf_(om[e]);
        *(u32x4*)(mix + (size_t)row * DM + c0) = pack8(f);
    }
}
#ifndef MK_PER_PHASE
#define MK_PER_PHASE 0
#endif
constexpr int NPHASE = 38;
#define AIN(i) ((const float*)(const GAS float*)ainq[i])
struct Args { const float* in[N_IN]; float* out; unsigned char* ws; int ph_lo, ph_hi; };
static_assert(sizeof(Args) == N_IN * 8 + 8 + 8 + 8, "Args has no padding");
constexpr int CW_BAR = 4096;
constexpr int I_EIN = 32 * 72, I_OIN = 16 * 20 * 8  , I_OUT = 32 * 32, I_UP = 32 * 176, I_DN = 88 * 32, I_UQ = 8 * 24, I_UKV = 4 * 32;

typedef const __attribute__((address_space(4))) unsigned long long* kargp_t;
DI void wconv(kargp_t ainq, unsigned char* ws, int layer, int part, long t0, long nt, int lane, LAS unsigned char* lw) {
    const int jh = layer >> 1; const bool odd = (layer & 1) != 0;
    const int nin = odd ? I_OIN : I_EIN, total = part ? (I_UP + I_DN) : (nin + I_OUT + (odd ? I_UQ + I_UKV : 0));
    unsigned* ctr = (unsigned*)ws + 64 * (1 + layer * 2 + part);
    for (;;) {
        unsigned base = 0u; if (lane == 0) base = __hip_atomic_fetch_add(ctr, 8u, __ATOMIC_RELAXED, __HIP_MEMORY_SCOPE_AGENT);
        base = (unsigned)__builtin_amdgcn_readfirstlane((int)base);
        if ((int)base >= total) break;
#pragma unroll 1
        for (int kk = 0; kk < 8; ++kk) {
            const int it = (int)base + kk; if (it >= total) break;
            int r = it, K, N; const float* W; bf16_t* WT;
            if (part) {
                if (r < I_UP) { W = AIN(I_FUP) + (size_t)layer * 2048 * DFF2; WT = (bf16_t*)(ws + WS_WUP + (size_t)layer * WUP_STRIDE); K = 2048; N = DFF2; }
                else { r -= I_UP; W = AIN(I_FDN) + (size_t)layer * DFF * 2048; WT = (bf16_t*)(ws + WS_WDN + (size_t)layer * WDN_STRIDE); K = DFF; N = 2048; }
            } else {
                if (r < nin) { W = odd ? AIN(I_OWIN) + (size_t)jh * 2048 * ODD_IN : AIN(I_EWIN) + (size_t)jh * 2048 * EVEN_IN; WT = (bf16_t*)(ws + WS_WIN + (size_t)layer * WIN_STRIDE); K = 2048; N = odd ? ODD_IN : EVEN_IN; }
                else if ((r -= nin) < I_OUT) { W = (odd ? AIN(I_OWOUT) : AIN(I_EWOUT)) + (size_t)jh * 2048 * 2048; WT = (bf16_t*)(ws + WS_WOUT + (size_t)layer * WOUT_STRIDE); K = 2048; N = 2048; }
                else if ((r -= I_OUT) < I_UQ) { W = AIN(I_WUQ) + (size_t)jh * 512 * 1536; WT = (bf16_t*)(ws + WS_WUQ + (size_t)jh * WUQ_STRIDE); K = 512; N = 1536; }
                else { r -= I_UQ; W = AIN(I_WUKV) + (size_t)jh * 256 * 2048; WT = (bf16_t*)(ws + WS_WUKV + (size_t)jh * WUKV_STRIDE); K = 256; N = 2048; }
            }
            p0_tr64(W, K, N, WT, r, lane, (part && N == DFF2) ? 1 : (!part && N == ODD_IN) ? 2 : 0, lw);
        }
    }
    if (!part && odd) { unsigned zz_ = 0u; asm volatile("" : "+v"(zz_));
        for (long i = t0; i < 40960; i += nt) *(u32x4*)((bf16_t*)(ws + WS_WIN + (size_t)layer * WIN_STRIDE) + (size_t)ODD_IN * 2048 + i * 8) = (u32x4){zz_, zz_, zz_, zz_}; }
}

__global__ void __launch_bounds__(NTHR, 2) fwd_kernel(Args args) {
    extern __shared__ __attribute__((aligned(16))) unsigned char lds_raw[];
    LAS unsigned char* lds = (LAS unsigned char*)lds_raw;
    const int tid0 = threadIdx.x; const int wave0 = __builtin_amdgcn_readfirstlane(tid0 >> 6);
    const int bid0 = blockIdx.x, nb = gridDim.x, ngw = nb * NWAVES;
    const long ngt = (long)nb * NTHR;
    unsigned char* const ws0 = args.ws; float* const out0 = args.out;
    const int lo = args.ph_lo, hi = args.ph_hi; const bool multi = (hi - lo) > 1;
    for (int u = tid0; u < (LDS_BYTES - LDSCTL_OFF) / 4; u += NTHR) ((LAS unsigned*)(lds + LDSCTL_OFF))[u] = 0u;
    __syncthreads();
    XcdBarrier bar; bar.bar = (unsigned*)ws0 + CW_BAR; bar.x = 0; bar.st = nullptr;
    if (multi) bar = xcd_barrier_post((unsigned*)ws0 + CW_BAR, (volatile LAS unsigned*)(lds + MISC_OFF) + 8);
    int pid = 0; (void)pid; (void)lo;
#if MK_PER_PHASE
#define PH_COND (pid >= lo && pid < hi)
#define PH_END   if (pid + 1 < hi) xcd_barrier_fast(bar, tid); } ++pid;
#define PH_END_FIRST if (pid + 1 < hi) xcd_barrier(bar, tid); } ++pid;
#define PH_END_LAST } ++pid;
#else
#define PH_COND (true)
#define PH_END   xcd_barrier_fast(bar, tid); }
#define PH_END_FIRST xcd_barrier(bar, tid); }
#define PH_END_LAST }
#endif
#define PH_BEGIN if (PH_COND) { unsigned full_ = ~0u; asm volatile("" : "+s"(full_)); int tid = wave0 * 64 + (int)__builtin_amdgcn_mbcnt_hi(full_, __builtin_amdgcn_mbcnt_lo(full_, 0u)); asm volatile("" : "+v"(tid));     \
    int bid = bid0; asm volatile("" : "+s"(bid));     \
    const int lane = tid & 63, wave = __builtin_amdgcn_readfirstlane(tid >> 6), gw = bid * NWAVES + wave; \
    const long gtid = (long)bid * NTHR + tid; (void)lane; (void)gw; (void)gtid; (void)wave; \
    unsigned long long ws_u = (unsigned long long)ws0, out_u = (unsigned long long)out0; const __attribute__((address_space(4))) unsigned long long* ainq = (const __attribute__((address_space(4))) unsigned long long*)__builtin_amdgcn_kernarg_segment_ptr(); \
    asm volatile("" : "+s"(ws_u), "+s"(out_u), "+s"(ainq)); unsigned char* ws = (unsigned char*)(GAS unsigned char*)ws_u; float* out = (float*)(GAS float*)out_u; (void)out; (void)ainq; \
    float* modraw = (float*)(ws + WS_MODRAW); float* tab = (float*)(ws + WS_ROPE); bf16_t* X = (bf16_t*)(ws + WS_X); bf16_t* H = (bf16_t*)(ws + WS_H); bf16_t* RAW = (bf16_t*)(ws + WS_RAW); bf16_t* MIX = (bf16_t*)(ws + WS_MIX); \
    bf16_t* U = (bf16_t*)(ws + WS_U); bf16_t* ACT = (bf16_t*)(ws + WS_ACT); bf16_t* PART = (bf16_t*)(ws + WS_PART); (void)PART; (void)modraw; (void)tab; (void)X; (void)H; (void)RAW; (void)MIX; (void)U; (void)ACT;

    PH_BEGIN
    {
        LAS float* sc = (LAS float*)lds; LAS float* red = (LAS float*)(lds + 24576);
        for (int i = tid; i < 3 * 2048; i += NTHR) { const int v = i >> 11, k = i & 2047; const float x = (v == 0) ? AIN(I_CCTX)[k] : AIN(I_C)[(v - 1) * 2048 + k]; sc[i] = siluf_(x); }
        __syncthreads();
        const float* wmod = AIN(I_WMOD);
        for (int item = bid; item < 4 * 192; item += nb) {
            const int l = item / 192, cc = item % 192, n = cc * 64 + lane, k0 = wave * 256;
            const float* wp = wmod + ((size_t)l * 2048 + k0) * 12288 + n;
            float s0 = 0.f, s1 = 0.f, s2 = 0.f;
#pragma unroll 32
            for (int k = 0; k < 256; ++k) { const float w = wp[(size_t)k * 12288]; s0 += sc[k0 + k] * w; s1 += sc[2048 + k0 + k] * w; s2 += sc[4096 + k0 + k] * w; }
            red[(wave * 3 + 0) * 64 + lane] = s0; red[(wave * 3 + 1) * 64 + lane] = s1; red[(wave * 3 + 2) * 64 + lane] = s2;
            __syncthreads();
            if (tid < 192) { const int v = tid >> 6, ln = tid & 63; float s = AIN(I_BMOD)[(size_t)l * 12288 + cc * 64 + ln];
#pragma unroll
                for (int w = 0; w < 8; ++w) s += red[(w * 3 + v) * 64 + ln];
                modraw[(size_t)(l * 3 + v) * 12288 + cc * 64 + ln] = s; }
            __syncthreads();
        }
    }
    for (long i = gtid; i < 2048; i += ngt) rope_table_entry(tab, (int)i);
#pragma unroll 1
    for (int q = 0; q < 2; ++q) wconv(ainq, ws, 0, q, gtid, ngt, lane, lds + wave * 9216);
    PH_END_FIRST

    for (int l = 0; l < 4; ++l) {
        const int j = l >> 1; const bool odd = (l & 1) != 0;
        const int NIN = odd ? ODD_INP : EVEN_IN;
        PH_BEGIN
        { const void* xc = (l == 0) ? (const void*)AIN(I_XP) : (const void*)X; const void* xd = (l == 0) ? (const void*)AIN(I_XS) : (const void*)(X + (size_t)NCTX * DM);
          norm_mod_rows(xc, l == 0, xd, l == 0, AIN(I_N1G) + l * 2048, modraw + (size_t)l * 3 * 12288, 0, H, (l == 0) ? (const float*)nullptr : modraw + (size_t)(l - 1) * 3 * 12288 + 5 * 2048, PART, X, gw, ngw, lane); }
        PH_END
        PH_BEGIN
        { const int npw = odd ? 19 : 18;
          pg8::Gemm g{H, (const bf16_t*)(ws + WS_WIN + (size_t)l * WIN_STRIDE), MTOK, NIN, 2048, 2048}; InOrder S; S.S0.init(MTOK, npw * 256, nb, bid); S.G = nb; S.c = bid; S.nW = 40 * npw; S.nQ = odd ? 160 : 0;
          EpiInQ E{pg8::EpiBf16<0>{RAW, NIN, nullptr, 0, 0, 1.f}, (bf16_t*)(ws + WS_U + 4 * MiB), npw};
          pg8::gemm_phase<EpiInQ, InOrder, true, true>(lds, g, S, E, tid); }
        {
            const int first = (nb == 256) ? (odd ? 152 : 208) : 0, nidle = nb - first;
            if (bid >= first) for (int it = (bid - first) * NWAVES + wave; it < 512; it += nidle * NWAVES) {
                if (!odd) epost_cache(it, j, AIN(I_CDAK), AIN(I_CDAV), AIN(I_CGQK), AIN(I_CGQV), (bf16_t*)(ws + WE_KAD), (bf16_t*)(ws + WE_KBD), (bf16_t*)(ws + WE_VTA_D), (bf16_t*)(ws + WE_VTB_D), lane);
                else opost_cache(it, j, AIN(I_CCKV), AIN(I_CKPE), (bf16_t*)(ws + WO_CKV), (bf16_t*)(ws + WO_KPE), lane); } }
        PH_END
        if (!odd) {
            PH_BEGIN
            bf16_t* KAd = (bf16_t*)(ws + WE_KAD); bf16_t* KBd = (bf16_t*)(ws + WE_KBD); bf16_t* VAd = (bf16_t*)(ws + WE_VTA_D); bf16_t* VBd = (bf16_t*)(ws + WE_VTB_D);
            for (int it = gw; it < 10240; it += ngw) {
                if (it < 10240) epost_row(RAW, it, j, out, AIN(I_GQQN) + j * 128, AIN(I_GQKN) + j * 128, KAd, KBd, VAd, VBd, tab, lane);
            }
            PH_END
            PH_BEGIN
            bf16_t* KAd = (bf16_t*)(ws + WE_KAD); bf16_t* KBd = (bf16_t*)(ws + WE_KBD); bf16_t* VAd = (bf16_t*)(ws + WE_VTA_D); bf16_t* VBd = (bf16_t*)(ws + WE_VTB_D);
            { const float lam_init = j ? 0.4707130183435842f : 0.2f;
              const int nit = (nb == 256) ? 4 : (640 + nb - 1) / nb;
#pragma unroll 1
              for (int i = 0; i < nit; ++i) {
                int kind = -1, idx = 0;
                if (nb == 256) {
                    if (bid < 64) { if (i == 0) { kind = 0; idx = bid; } }
                    else if (bid < 128) { if (i == 0) { kind = 1; idx = bid - 64; } else if (i == 1) { kind = 1; idx = 64 + (bid - 64); } }
                    else { const int k = bid - 128; if (i == 0) { kind = 0; idx = 64 + k; } else if (i == 1) { kind = 0; idx = 64 + 128 + k; } else if (i == 2) { kind = 1; idx = 64 + 64 + k; } else if (k < 64) { kind = 1; idx = 64 + 192 + k; } }
                } else { const int u = bid + i * nb; if (u < 64) { kind = 0; idx = u; } else if (u < 128) { kind = 1; idx = u - 64; } else if (u < 384) { kind = 0; idx = 64 + (u - 128); } else if (u < 640) { kind = 1; idx = 64 + (u - 384); } }
                if (kind == 0) da_unit(idx, j, RAW, KAd, VAd, AIN(I_DALAM), AIN(I_DALN), lam_init, MIX, tab, lds, tid);
                else if (kind == 1) gqa_unit(idx, RAW, KBd, VBd, MIX, AIN(I_GQQN) + j * 128, tab, lds, tid);
              }
              __syncthreads();
              wconv(ainq, ws, l + 1 - (l >> 1), l >> 1, gtid, ngt, lane, lds + wave * 9216); }
            PH_END
        } else {
            PH_BEGIN
            bf16_t* QM = (bf16_t*)(ws + WO_QM); bf16_t* KM = (bf16_t*)(ws + WO_KM); float* G = (float*)(ws + WO_G); bf16_t* QD = (bf16_t*)(ws + WO_QD); bf16_t* CKV = (bf16_t*)(ws + WO_CKV); bf16_t* KPE = (bf16_t*)(ws + WO_KPE); bf16_t* CQ = (bf16_t*)(ws + WO_CQ); bf16_t* KV = (bf16_t*)(ws + WO_KV); bf16_t* HF = (bf16_t*)(ws + WO_HF);
            for (int it = gw; it < 10240 + 5120; it += ngw) {
                if (it < 10240) opost_row(RAW, (const bf16_t*)(ws + WS_U + 4 * MiB), it, j, out, AIN(I_MLGB), AIN(I_MLAQN), AIN(I_MLAKVN), G, QD, CKV, KPE, tab, lane);
                else opost_conv(RAW, it - 10240, j, AIN(I_MLCW), AIN(I_MLCB), QM, KM, lane);
            }
            PH_END
            PH_BEGIN
            bf16_t* QM = (bf16_t*)(ws + WO_QM); bf16_t* KM = (bf16_t*)(ws + WO_KM); float* G = (float*)(ws + WO_G); bf16_t* QD = (bf16_t*)(ws + WO_QD); bf16_t* CKV = (bf16_t*)(ws + WO_CKV); bf16_t* KPE = (bf16_t*)(ws + WO_KPE); bf16_t* CQ = (bf16_t*)(ws + WO_CQ); bf16_t* KV = (bf16_t*)(ws + WO_KV); bf16_t* HF = (bf16_t*)(ws + WO_HF);
            { pg8::Gemm g{QD, (const bf16_t*)(ws + WS_WUQ + (size_t)j * WUQ_STRIDE), MTOK, 1536, 512, 512}; pg8::StaticOrder S; S.init(MTOK, 1536, nb, bid);
              pg8::EpiBf16<0> E{CQ, 1536, nullptr, 0, 0, 1.f};
              pg8::gemm_phase<pg8::EpiBf16<0>, pg8::StaticOrder, true, true>(lds, g, S, E, tid); }
            { pg8::Gemm g{CKV, (const bf16_t*)(ws + WS_WUKV + (size_t)j * WUKV_STRIDE), MKV, 2048, 256, 256}; pg8::StaticOrder S; S.init(MKV, 2048, nb, bid);
              pg8::EpiBf16<0> E{KV, 2048, nullptr, 0, 0, 1.f};
              pg8::gemm_phase<pg8::EpiBf16<0>, pg8::StaticOrder, true, true>(lds, g, S, E, tid); }
            PH_END
            PH_BEGIN
            bf16_t* QM = (bf16_t*)(ws + WO_QM); bf16_t* KM = (bf16_t*)(ws + WO_KM); float* G = (float*)(ws + WO_G); bf16_t* QD = (bf16_t*)(ws + WO_QD); bf16_t* CKV = (bf16_t*)(ws + WO_CKV); bf16_t* KPE = (bf16_t*)(ws + WO_KPE); bf16_t* CQ = (bf16_t*)(ws + WO_CQ); bf16_t* KV = (bf16_t*)(ws + WO_KV); bf16_t* HF = (bf16_t*)(ws + WO_HF);
            { LAS float* scb = (LAS float*)(lds + LDSCTL_OFF + 1024);
              const int nml = (nb == 256) ? 2 : (32 + 256 + nb - 1) / nb;
#pragma unroll 1
              for (int i = 0; i < nml; ++i) {
                int u = -1, ds = -1;
                if (nb == 256) { if (bid < 32) { if (i == 0) { u = bid >> 1; ds = bid & 1; } } else { const int k = bid - 32; if (i == 0) u = 16 + k; else if (k < 32) u = 16 + 224 + k; } }
                else { const int uu = bid + i * nb; if (uu < 32) { u = uu >> 1; ds = uu & 1; } else if (uu < 288) u = 16 + (uu - 32); }
                if (u >= 0) mlstm_wg(u, ds, j, QM, KM, RAW, G, AIN(I_SC), AIN(I_SN), AIN(I_SM), HF, out, AIN(I_MLNG) + j * 128, MIX, lds, scb, tid);
              }
              const int nit = (nb == 256) ? 2 : (320 + nb - 1) / nb;
#pragma unroll 1
              for (int i = 0; i < nit; ++i) {
                int idx = -1;
                if (nb == 256) { if (bid >= 64 && bid < 128) { if (i == 0) idx = bid - 64; } else if (bid >= 128) { const int k = bid - 128; if (i == 0) idx = 64 + k; else idx = 64 + 128 + k; } }
                else { const int u = bid + i * nb; if (u < 320) idx = u; }
                if (idx >= 0) mla_unit(idx, CQ, KV, KPE, MIX, tab, lds, tid);
              }
              { const int nq = (l == 1) ? 3 : 1;
#pragma unroll 1
                for (int q = 0; q < nq; ++q) { const int cl = (l == 1) ? 1 + q : 3, cp = (l == 1) ? (q == 0 ? 1 : 0) : 1; wconv(ainq, ws, cl, cp, gtid, ngt, lane, lds + wave * 9216); } } }
            PH_END
            PH_BEGIN
            bf16_t* QM = (bf16_t*)(ws + WO_QM); bf16_t* KM = (bf16_t*)(ws + WO_KM); float* G = (float*)(ws + WO_G); bf16_t* QD = (bf16_t*)(ws + WO_QD); bf16_t* CKV = (bf16_t*)(ws + WO_CKV); bf16_t* KPE = (bf16_t*)(ws + WO_KPE); bf16_t* CQ = (bf16_t*)(ws + WO_CQ); bf16_t* KV = (bf16_t*)(ws + WO_KV); bf16_t* HF = (bf16_t*)(ws + WO_HF);
            for (int row = NCTX + gw; row < MTOK; row += ngw) opmix_row(HF, RAW, row, AIN(I_MLNG) + j * 128, MIX, lane);
            PH_END
        }
        PH_BEGIN
        {
          const void* xc = (l == 0) ? (const void*)AIN(I_XP) : (const void*)X;
          pg8::Gemm g{MIX, (const bf16_t*)(ws + WS_WOUT + (size_t)l * WOUT_STRIDE), MTOK, 2048, 2048, 2048}; OutOrder S; S.G = nb; S.c = bid; S.Kq = 512;
          EpiResPart E{EpiResid{xc, l == 0, X, modraw + (size_t)l * 3 * 12288 + 2 * 2048}, EpiPart{PART - (size_t)NCTX * DM}};
          pg8::gemm_phase<EpiResPart, OutOrder, true, true>(lds, g, S, E, tid); }
        PH_END
        PH_BEGIN
        norm_mod_rows(X, 0, (l == 0) ? (const void*)AIN(I_XS) : (const void*)(X + (size_t)NCTX * DM), l == 0, AIN(I_N2G) + l * 2048, modraw + (size_t)l * 3 * 12288, 3, H, modraw + (size_t)l * 3 * 12288 + 2 * 2048, PART, X, gw, ngw, lane);
        PH_END
        PH_BEGIN
        { pg8::Gemm g{H, (const bf16_t*)(ws + WS_WUP + (size_t)l * WUP_STRIDE), MTOK, DFF2, 2048, 2048}; pg8::StaticOrder S; S.init(MTOK, DFF2, nb, bid);
          EpiUp E{(float*)U, ACT, AIN(I_FCW) + (size_t)l * 3 * DFF2, AIN(I_FCB) + (size_t)l * DFF2, (LAS float*)(lds + 131072)};
          pg8::gemm_phase<EpiUp, pg8::StaticOrder, true, true>(lds, g, S, E, tid); }
        PH_END
        PH_BEGIN
        { pg8::Gemm g{ACT, (const bf16_t*)(ws + WS_WDN + (size_t)l * WDN_STRIDE), MTOK, 2048, DFF, DFF}; OutOrder S; S.G = nb; S.c = bid; S.Kq = DFF / 4;
          for (int i = 0; i * nb < 512; ++i) { const int L = S.latent_of(i); if (L >= 0) ffn_edge_fix(L, (const float*)U, AIN(I_FCW) + (size_t)l * 3 * DFF2, AIN(I_FCB) + (size_t)l * DFF2, ACT, tid); }
          asm volatile("s_waitcnt vmcnt(0)" ::: "memory"); __syncthreads();
          EpiResPart E{EpiResid{X, 0, X, modraw + (size_t)l * 3 * 12288 + 5 * 2048}, EpiPart{PART - (size_t)NCTX * DM}};
          pg8::gemm_phase<EpiResPart, OutOrder, true, true>(lds, g, S, E, tid); }
        PH_END
    }
    PH_BEGIN
    final_norm_rows(X, AIN(I_FNG), out, modraw + (size_t)3 * 3 * 12288 + 5 * 2048, PART, gw, ngw, lane);
    PH_END_LAST
#undef PH_BEGIN
#undef PH_END
#undef PH_END_LAST
#undef PH_END_FIRST
#undef PH_COND
}

extern "C" void kernel_launch(void* const* d_in, const int* in_sizes, int n_in, void* d_out, int out_size, void* d_ws, size_t ws_size, hipStream_t stream) {
    static int grid = 0;
    if (grid == 0) {
        if (n_in != N_IN || (size_t)out_size != O_END || ws_size < WS_END) { fprintf(stderr, "kernel_launch: unexpected shapes: n_in %d out %d ws %zu (need %zu)\n", n_in, out_size, ws_size, (size_t)WS_END); grid = -1; return; }
        int dev = 0, cus = 0, per_cu = 0;
        if (hipGetDevice(&dev) != hipSuccess || hipDeviceGetAttribute(&cus, hipDeviceAttributeMultiprocessorCount, dev) != hipSuccess) { grid = -1; return; }
        if (hipFuncSetAttribute((const void*)fwd_kernel, hipFuncAttributeMaxDynamicSharedMemorySize, LDS_BYTES) != hipSuccess) { fprintf(stderr, "kernel_launch: hipFuncSetAttribute failed\n"); grid = -1; return; }
        if (hipOccupancyMaxActiveBlocksPerMultiprocessor(&per_cu, (const void*)fwd_kernel, NTHR, LDS_BYTES) != hipSuccess || per_cu < 1) fprintf(stderr, "kernel_launch: occupancy query says %d\n", per_cu);
        (void)hipGetLastError();
        grid = cus;
    }
    if (grid < 0) return;
    if (hipMemsetAsync((char*)d_ws + WS_CTL, 0, CTL_ZERO_BYTES, stream) != hipSuccess) { fprintf(stderr, "kernel_launch: memset failed\n"); return; }
    Args a{};
    for (int i = 0; i < N_IN; ++i) a.in[i] = (const float*)d_in[i];
    a.out = (float*)d_out; a.ws = (unsigned char*)d_ws;
#if MK_PER_PHASE
    for (int p = 0; p < NPHASE; ++p) { a.ph_lo = p; a.ph_hi = p + 1; hipLaunchKernelGGL(fwd_kernel, dim3(grid), dim3(NTHR), LDS_BYTES, stream, a); }
#else
    a.ph_lo = 0; a.ph_hi = NPHASE; hipLaunchKernelGGL(fwd_kernel, dim3(grid), dim3(NTHR), LDS_BYTES, stream, a);
#endif
    const hipError_t le = hipPeekAtLastError();
    if (le != hipSuccess) fprintf(stderr, "kernel_launch: launch failed: %s\n", hipGetErrorName(le));
}
```

```cpp
#include <hip/hip_runtime.h>
#include <cstdio>
#include <cstdint>

namespace pg8 {
#define PG8_LAS __attribute__((address_space(3)))
typedef unsigned short bf16_t;
typedef short bf16x8 __attribute__((ext_vector_type(8)));
typedef float f32x4 __attribute__((ext_vector_type(4)));
typedef unsigned u32x4 __attribute__((ext_vector_type(4)));
constexpr int BM = 256, BK = 64, HALF = 128, HTB = HALF * BK * 2  , STAGE_BYTES = 8 * HTB, NXCD = 8, WGM = 8;

__host__ __device__ __forceinline__ int lds_byte(int r, int c) { const int st = (r >> 4) * 2 + (c >> 5), rr = r & 15, cc = c & 31, ob = rr * 64 + cc * 2; return st * 1024 + (ob ^ (((ob >> 9) & 1) << 5)); }
__host__ __device__ __forceinline__ void stage_rc(int b, int& R, int& C) { const int st = b / 1024, sb = b % 1024, swz = sb ^ (((sb >> 9) & 1) << 5); R = (st >> 1) * 16 + swz / 64; C = (st & 1) * 32 + (swz % 64) / 2; }
__host__ __device__ __forceinline__ int perm32(int rho) { const int n = rho >> 4, i = rho & 15; return 8 * (i >> 2) + 4 * n + (i & 3); }

struct Unit { int pm, pn, koff, ks; };
struct Gemm { const bf16_t* A; const bf16_t* Bt; int M, N, K, ld; };

struct StaticOrder {
    int nM, nN, nwg, G, c;
    __host__ __device__ void init(int M, int N, int G_, int c_) { nM = M / BM; nN = N / BM; nwg = nM * nN; G = G_; c = c_; }
    __host__ __device__ bool next(int i, Unit& u) const {
        const long L = (long)i * G + c; if (L >= nwg) return false;
        int wgid = (int)L; { const int q = nwg / NXCD, r = nwg % NXCD, xcd = wgid % NXCD, off = wgid / NXCD; wgid = (xcd < r ? xcd * (q + 1) : r * (q + 1) + (xcd - r) * q) + off; }
        const int nig = WGM * nN, gid = wgid / nig, fm = gid * WGM, gsz = (nM - fm) < WGM ? (nM - fm) : WGM;
        u.pm = fm + ((wgid % nig) % gsz); u.pn = (wgid % nig) / gsz; u.koff = 0; u.ks = 0; return true;
    }
    __device__ __forceinline__ void a_ready(const Unit&) const {}
    __device__ __forceinline__ void done(const Unit&) const {}
    __device__ __forceinline__ int unit_nt(const Unit&, int nt_gemm) const { return nt_gemm; }
};

__device__ __forceinline__ unsigned cvt_pk_bf16(float lo, float hi) { unsigned r; asm volatile("v_cvt_pk_bf16_f32 %0, %1, %2" : "=v"(r) : "v"(lo), "v"(hi)); return r; }
typedef float f32x2 __attribute__((ext_vector_type(2)));
__device__ __forceinline__ f32x2 gelu_pk(f32x2 v) {
    const f32x2 av = __builtin_elementwise_abs(v), d = av * 0.2316418882f + 1.0f;
    f32x2 t; t.x = __builtin_amdgcn_rcpf(d.x); t.y = __builtin_amdgcn_rcpf(d.y);
    f32x2 q = t * 0.5307027145f + (-0.7265760135f); q = q * t + 0.7107068705f; q = q * t + (-0.142248368f); q = q * t + 0.127414796f; q = q * t;
    const f32x2 s = (v * v) * (-0.72134752044f);
    f32x2 e; e.x = __builtin_amdgcn_exp2f(s.x); e.y = __builtin_amdgcn_exp2f(s.y);
    const f32x2 m = v * (q * e), r = v - m;
    f32x2 o; o.x = v.x < 0.f ? m.x : r.x; o.y = v.y < 0.f ? m.y : r.y; return o;
}

template <int ACT  > struct EpiBf16 {
    static constexpr bool PERM = true, AFTER_DRAIN = false, ROWPERM = false; static_assert(ACT == 0 || ACT == 1, "EpiBf16: ACT is 0 (none) or 1 (gelu_pk)");
    bf16_t* O; int ldc; const float* bias; int split_cols; size_t split_stride; float scale0;
    __device__ __forceinline__ void operator()(const f32x4 (&acc)[2][2][4][2], const Unit& u, int wr, int wc, int fr, int fq) const {
        const int row0 = u.pm * BM + wr * 64 + fr; int colt = u.pn * BM; bf16_t* base = O;
        float sc = 1.f; if (split_cols) { const int t = colt / split_cols; base += (size_t)t * split_stride; colt -= t * split_cols; if (t == 0) sc = scale0; }
        const int col0 = colt + wc * 32 + 8 * fq, bcol0 = u.pn * BM + wc * 32 + 8 * fq;
        f32x4 bv[2][2];
#pragma unroll
        for (int bj = 0; bj < 2; ++bj)
#pragma unroll
            for (int n = 0; n < 2; ++n) bv[bj][n] = bias ? *(const f32x4*)(bias + bcol0 + bj * HALF + 4 * n) : (f32x4){0.f, 0.f, 0.f, 0.f};
#pragma unroll
        for (int ai = 0; ai < 2; ++ai)
#pragma unroll
            for (int m = 0; m < 4; ++m) { bf16_t* rowp = base + (size_t)(row0 + ai * HALF + m * 16) * ldc + col0;
#pragma unroll
                for (int bj = 0; bj < 2; ++bj) { f32x4 v0 = acc[ai][bj][m][0] + bv[bj][0], v1 = acc[ai][bj][m][1] + bv[bj][1];
                    if (ACT == 1) { f32x2 a = gelu_pk((f32x2){v0[0], v0[1]}), b = gelu_pk((f32x2){v0[2], v0[3]}), c = gelu_pk((f32x2){v1[0], v1[1]}), d = gelu_pk((f32x2){v1[2], v1[3]});
                        v0 = (f32x4){a.x, a.y, b.x, b.y}; v1 = (f32x4){c.x, c.y, d.x, d.y}; }
                    v0 = v0 * sc; v1 = v1 * sc; u32x4 w; w.x = cvt_pk_bf16(v0[0], v0[1]); w.y = cvt_pk_bf16(v0[2], v0[3]); w.z = cvt_pk_bf16(v1[0], v1[1]); w.w = cvt_pk_bf16(v1[2], v1[3]);
                    *(u32x4*)(rowp + bj * HALF) = w; } }
    }
};

template <class Epi, class Sched, bool ALIGN_EPI = false, bool SP2 = false>
__device__ __forceinline__ void gemm_phase(PG8_LAS unsigned char* lds, const Gemm g, const Sched& S, const Epi& E, const int tid) {
    const int wid = __builtin_amdgcn_readfirstlane(tid >> 6), lane = tid & 63, wr = wid >> 2, wc = wid & 3, fr = lane & 15, fq = lane >> 4;
    const int K = g.ld;
    unsigned voffA[2], voffB[2];
#pragma unroll
    for (int i = 0; i < 2; ++i) { int R, C; stage_rc(tid * 16 + i * 8192, R, C); const int Rb = Epi::PERM ? ((R & ~31) + perm32(R & 31)) : R;
        const int Ra = Epi::ROWPERM ? (8 * (16 * (R >> 6) + (R & 15)) + ((R >> 4) & 3)) : R;
        voffA[i] = (unsigned)(Ra * K + C) * 2u; voffB[i] = (unsigned)(Rb * K + C) * 2u; }
    const size_t kstep = (size_t)(BK * 2);
    const size_t hstep = (size_t)HALF * K * 2;
    const size_t tstep = 2 * hstep;
    const size_t hstepA = Epi::ROWPERM ? (size_t)4 * K * 2 : hstep;
    const unsigned ldsw = (unsigned)wid * 1024u;
    const int aoff = lds_byte(wr * 64 + fr, fq * 8), boff = lds_byte(wc * 32 + fr, fq * 8);
#define PG8_SA(b, h) (((b) * 2 + (h)) * HTB)
#define PG8_SB(b, h) ((4 + (b) * 2 + (h)) * HTB)
#define PG8_STAGE(bufoff, gbase, voff) do { _Pragma("unroll") for (int _i = 0; _i < 2; ++_i) \
        __builtin_amdgcn_global_load_lds((const unsigned*)((const char*)(gbase) + (voff)[_i]), (PG8_LAS unsigned*)(lds + (bufoff) + ldsw + _i * 8192), 16, 0, 0); } while (0)
#define PG8_LDA(dst, b, h) do { _Pragma("unroll") for (int m = 0; m < 4; ++m) _Pragma("unroll") for (int k = 0; k < 2; ++k) dst[m][k] = *(const PG8_LAS bf16x8*)(lds + PG8_SA(b, h) + aoff + m * 2048 + k * 1024); } while (0)
#define PG8_LDB(dst, b, h) do { _Pragma("unroll") for (int n = 0; n < 2; ++n) _Pragma("unroll") for (int k = 0; k < 2; ++k) dst[n][k] = *(const PG8_LAS bf16x8*)(lds + PG8_SB(b, h) + boff + n * 2048 + k * 1024); } while (0)
#define PG8_MMA(ai, bj, At, Bt) do { __builtin_amdgcn_s_setprio(1); _Pragma("unroll") for (int m = 0; m < 4; ++m) _Pragma("unroll") for (int n = 0; n < 2; ++n) _Pragma("unroll") for (int k = 0; k < 2; ++k) \
        acc[ai][bj][m][n] = __builtin_amdgcn_mfma_f32_16x16x32_bf16(Bt[n][k], At[m][k], acc[ai][bj][m][n], 0, 0, 0); __builtin_amdgcn_s_setprio(0); } while (0)
#define PG8_WAIT_V(n) asm volatile("s_waitcnt vmcnt(" #n ")" ::: "memory")
#define PG8_WAIT_L(n) asm volatile("s_waitcnt lgkmcnt(" #n ")" ::: "memory")
#define PG8_BAR __builtin_amdgcn_s_barrier()
#define PG8_SCHED __builtin_amdgcn_sched_barrier(0)
    Unit cur, nxt; int ui = 0;
    if (!S.next(0, cur)) return;
    int nt = S.unit_nt(cur, g.K / BK);
    f32x4 acc[2][2][4][2];
#pragma unroll
    for (int a = 0; a < 2; ++a)
#pragma unroll
        for (int b = 0; b < 2; ++b)
#pragma unroll
            for (int m = 0; m < 4; ++m)
#pragma unroll
                for (int n = 0; n < 2; ++n) acc[a][b][m][n] = (f32x4){0.f, 0.f, 0.f, 0.f};
    bf16x8 At[4][2], B0[2][2], B1[2][2];
    const char* cA = (const char*)g.A + (size_t)cur.pm * tstep + (size_t)cur.koff * 2; const char* cB = (const char*)g.Bt + (size_t)cur.pn * tstep + (size_t)cur.koff * 2;
    S.a_ready(cur);
    if constexpr (SP2) {
        PG8_STAGE(PG8_SB(0, 0), cB, voffB); PG8_STAGE(PG8_SB(0, 1), cB + hstep, voffB); PG8_STAGE(PG8_SA(0, 0), cA, voffA); PG8_STAGE(PG8_SA(0, 1), cA + hstepA, voffA);
        if (wr == 1) PG8_BAR;
        PG8_WAIT_V(2); PG8_BAR;
        PG8_STAGE(PG8_SB(1, 0), cB + kstep, voffB); PG8_STAGE(PG8_SA(1, 0), cA + kstep, voffA); PG8_STAGE(PG8_SB(1, 1), cB + hstep + kstep, voffB);
        PG8_WAIT_V(6); PG8_BAR;
    } else {
        PG8_STAGE(PG8_SB(0, 0), cB, voffB); PG8_STAGE(PG8_SA(0, 0), cA, voffA); PG8_STAGE(PG8_SB(0, 1), cB + hstep, voffB); PG8_STAGE(PG8_SA(0, 1), cA + hstepA, voffA);
        if (wr == 1) PG8_BAR;
        PG8_WAIT_V(4); PG8_BAR;
        PG8_STAGE(PG8_SB(1, 0), cB + kstep, voffB); PG8_STAGE(PG8_SA(1, 0), cA + kstep, voffA); PG8_STAGE(PG8_SB(1, 1), cB + hstep + kstep, voffB);
        PG8_WAIT_V(6); PG8_BAR;
    }
    for (;;) {
        const bool has_next = S.next(ui + 1, nxt);
        const char* nA = has_next ? (const char*)g.A + (size_t)nxt.pm * tstep + (size_t)nxt.koff * 2 : cA; const char* nB = has_next ? (const char*)g.Bt + (size_t)nxt.pn * tstep + (size_t)nxt.koff * 2 : cB;
        for (int t = 0; t < nt; t += 2) {
            const bool last = (t == nt - 2);
            const char* a1 = cA + (size_t)(t + 1) * kstep;
            const char* a2 = last ? nA : cA + (size_t)(t + 2) * kstep; const char* b2 = last ? nB : cB + (size_t)(t + 2) * kstep;
            const char* a3 = a2 + kstep; const char* b3 = b2 + kstep;
            if (last && has_next) S.a_ready(nxt);
            if constexpr (SP2) {
            PG8_LDB(B0, 0, 0); PG8_LDB(B1, 0, 1); PG8_SCHED; PG8_LDA(At, 0, 0); PG8_STAGE(PG8_SA(1, 1), a1 + hstepA, voffA);
            PG8_WAIT_V(8); PG8_WAIT_L(0); PG8_BAR; PG8_MMA(0, 0, At, B0); PG8_MMA(0, 1, At, B1); PG8_BAR; PG8_SCHED;
            PG8_LDA(At, 0, 1); PG8_STAGE(PG8_SB(0, 0), b2, voffB); PG8_STAGE(PG8_SB(0, 1), b2 + hstep, voffB); PG8_STAGE(PG8_SA(0, 0), a2, voffA);
            PG8_WAIT_V(8); PG8_WAIT_L(0); PG8_BAR; PG8_MMA(1, 0, At, B0); PG8_MMA(1, 1, At, B1); PG8_BAR; PG8_SCHED;
            PG8_LDB(B0, 1, 0); PG8_LDB(B1, 1, 1); PG8_SCHED; PG8_LDA(At, 1, 0); PG8_STAGE(PG8_SA(0, 1), a2 + hstepA, voffA);
            PG8_WAIT_V(8); PG8_WAIT_L(0); PG8_BAR; PG8_MMA(0, 0, At, B0); PG8_MMA(0, 1, At, B1); PG8_BAR; PG8_SCHED;
            PG8_LDA(At, 1, 1); PG8_STAGE(PG8_SB(1, 0), b3, voffB); PG8_STAGE(PG8_SB(1, 1), b3 + hstep, voffB); PG8_STAGE(PG8_SA(1, 0), a3, voffA);
            PG8_WAIT_V(8); PG8_WAIT_L(0); PG8_BAR; PG8_MMA(1, 0, At, B0); PG8_MMA(1, 1, At, B1); PG8_BAR; PG8_SCHED;
            } else {
            PG8_LDB(B0, 0, 0); PG8_SCHED; PG8_LDA(At, 0, 0); PG8_STAGE(PG8_SA(1, 1), a1 + hstepA, voffA);
            PG8_WAIT_L(8); PG8_BAR; PG8_WAIT_L(0); PG8_MMA(0, 0, At, B0); PG8_BAR; PG8_SCHED;
            PG8_LDB(B1, 0, 1); PG8_STAGE(PG8_SB(0, 0), b2, voffB);
            PG8_BAR; PG8_WAIT_L(0); PG8_MMA(0, 1, At, B1); PG8_BAR;
            PG8_LDA(At, 0, 1); PG8_STAGE(PG8_SA(0, 0), a2, voffA);
            PG8_BAR; PG8_WAIT_L(0); PG8_MMA(1, 0, At, B0); PG8_BAR; PG8_SCHED;
            PG8_STAGE(PG8_SB(0, 1), b2 + hstep, voffB);
            PG8_WAIT_V(6); PG8_BAR; PG8_MMA(1, 1, At, B1); PG8_BAR;
            PG8_LDB(B0, 1, 0); PG8_SCHED; PG8_LDA(At, 1, 0); PG8_STAGE(PG8_SA(0, 1), a2 + hstepA, voffA);
            PG8_WAIT_L(8); PG8_BAR; PG8_WAIT_L(0); PG8_MMA(0, 0, At, B0); PG8_BAR; PG8_SCHED;
            PG8_LDB(B1, 1, 1); PG8_STAGE(PG8_SB(1, 0), b3, voffB);
            PG8_BAR; PG8_WAIT_L(0); PG8_MMA(0, 1, At, B1); PG8_BAR;
            PG8_LDA(At, 1, 1); PG8_STAGE(PG8_SA(1, 0), a3, voffA);
            PG8_BAR; PG8_WAIT_L(0); PG8_MMA(1, 0, At, B0); PG8_BAR; PG8_SCHED;
            PG8_STAGE(PG8_SB(1, 1), b3 + hstep, voffB);
            PG8_WAIT_V(6); PG8_BAR; PG8_MMA(1, 1, At, B1); PG8_BAR;
            }
        }
        if constexpr (ALIGN_EPI) { if (wr == 0) PG8_BAR; }
        if constexpr (!Epi::AFTER_DRAIN) { E(acc, cur, wr, wc, fr, fq); S.done(cur); }
        if (!has_next) break;
#pragma unroll
        for (int a = 0; a < 2; ++a)
#pragma unroll
            for (int b = 0; b < 2; ++b)
#pragma unroll
                for (int m = 0; m < 4; ++m)
#pragma unroll
                    for (int n = 0; n < 2; ++n) acc[a][b][m][n] = (f32x4){0.f, 0.f, 0.f, 0.f};
        cur = nxt; cA = nA; cB = nB; ++ui; nt = S.unit_nt(cur, g.K / BK);
        if constexpr (ALIGN_EPI) { if (wr == 1) PG8_BAR; }
    }
    PG8_WAIT_V(0);
    if constexpr (!ALIGN_EPI) { if (wr == 0) PG8_BAR; }
    PG8_BAR;
    if constexpr (Epi::AFTER_DRAIN) { E.fused(acc, cur, wr, wc, fr, fq, lds, wid, lane); S.done(cur); }
#undef PG8_SA
#undef PG8_SB
#undef PG8_STAGE
#undef PG8_LDA
#undef PG8_LDB
#undef PG8_MMA
#undef PG8_WAIT_V
#undef PG8_WAIT_L
#undef PG8_BAR
#undef PG8_SCHED
}
}
#define DI __device__ __forceinline__
#define GAS __attribute__((address_space(1)))
#define LAS __attribute__((address_space(3)))
using pg8::bf16_t; using pg8::bf16x8; using pg8::f32x4; using pg8::u32x4;
typedef float f32x16 __attribute__((ext_vector_type(16)));
typedef float f32x2 __attribute__((ext_vector_type(2)));
typedef short s16x4 __attribute__((ext_vector_type(4)));
typedef unsigned u32x2 __attribute__((ext_vector_type(2)));
typedef __bf16 bf16x2_t __attribute__((ext_vector_type(2)));

constexpr int DM = 2048, NCTX = 8192, NDEC = 2048, MTOK = 10240, MKV = 10752;
constexpr int EVEN_IN = 4608, ODD_IN = 4960, ODD_INP = 5120, DFF = 5632, DFF2 = 11264;
constexpr float EPS = 1e-6f;
constexpr int NWAVES = 8, NTHR = 512;
enum { I_XP = 0, I_XS, I_CDAK, I_CDAV, I_CGQK, I_CGQV, I_CCKV, I_CKPE, I_SC, I_SN, I_SM, I_C, I_CCTX, I_N1G, I_N2G, I_WMOD, I_BMOD,
       I_EWIN, I_EWOUT, I_DALAM, I_DALN, I_GQQN, I_GQKN, I_OWIN, I_OWOUT, I_MLCW, I_MLCB, I_MLGB, I_MLNG, I_MLAQN, I_WUQ, I_MLAKVN, I_WUKV,
       I_FUP, I_FCW, I_FCB, I_FDN, I_FNG, N_IN };
constexpr size_t O_YP = 0, O_YS = 16777216, O_DAK = 20971520, O_DAV = 37748736, O_GQK = 54525952, O_GQV = 58720256, O_CKV = 62914560,
                 O_KPE = 67108864, O_MLC = 68157440, O_MLN = 84934656, O_MLM = 85065728, O_END = 85066752;
constexpr size_t MiB = 1u << 20;
constexpr size_t WS_CTL = 0, CTL_ZERO_BYTES = 65536;
constexpr size_t WS_MODRAW = 1 * MiB;
constexpr size_t WS_ROPE = 2 * MiB;
constexpr size_t WS_WIN = 4 * MiB, WIN_STRIDE = 20 * MiB;
constexpr size_t WS_WOUT = 84 * MiB, WOUT_STRIDE = 8 * MiB;
constexpr size_t WS_WUP = 116 * MiB, WUP_STRIDE = 44 * MiB;
constexpr size_t WS_WDN = 292 * MiB, WDN_STRIDE = 22 * MiB;
constexpr size_t WS_WUQ = 380 * MiB, WUQ_STRIDE = 1536 * 512 * 2;
constexpr size_t WS_WUKV = 383 * MiB, WUKV_STRIDE = 1 * MiB;
constexpr size_t WS_X = 386 * MiB;
constexpr size_t WS_H = 466 * MiB;
constexpr size_t WS_RAW = 506 * MiB;
constexpr size_t WS_MIX = 606 * MiB;
constexpr size_t WS_U = 646 * MiB;
constexpr size_t WS_ACT = 866 * MiB;
constexpr size_t WS_ATT = 976 * MiB;
constexpr size_t WE_KAD = WS_ATT + 0 * MiB;
constexpr size_t WE_KBD = WS_ATT + 5 * MiB;
constexpr size_t WE_VTA_C = WS_ATT + 8 * MiB;
constexpr size_t WE_VTA_D = WS_ATT + 24 * MiB;
constexpr size_t WE_VTB_C = WS_ATT + 30 * MiB;
constexpr size_t WE_VTB_D = WS_ATT + 34 * MiB;
constexpr size_t WO_QM = WS_ATT + 0 * MiB;
constexpr size_t WO_KM = WS_ATT + 20 * MiB;
constexpr size_t WO_KMT = WS_ATT + 40 * MiB;
constexpr size_t WO_VMT = WS_ATT + 60 * MiB;
constexpr size_t WO_G = WS_ATT + 80 * MiB;
constexpr size_t WO_QD = WS_ATT + 82 * MiB;
constexpr size_t WO_CKV = WS_ATT + 92 * MiB;
constexpr size_t WO_KPE = WS_ATT + 98 * MiB;
constexpr size_t WO_CQ = WS_ATT + 100 * MiB;
constexpr size_t WO_KV = WS_ATT + 130 * MiB;
constexpr size_t WO_VTM_C = WS_ATT + 172 * MiB;
constexpr size_t WO_VTM_D = WS_ATT + 188 * MiB;
constexpr size_t WO_HF = WS_ATT + 194 * MiB;
constexpr size_t WS_PART = WS_ATT + 274 * MiB;
constexpr size_t WS_END = WS_PART + 64 * MiB;
constexpr int RING_BYTES = 147456, LDSCTL_OFF = RING_BYTES, MISC_OFF = LDSCTL_OFF + 320, LDS_BYTES = 163840;

DI unsigned pk2(float lo, float hi) { f32x2 v = {lo, hi}; bf16x2_t b = __builtin_convertvector(v, bf16x2_t); return __builtin_bit_cast(unsigned, b); }
DI float bf_lo(unsigned w) { return __uint_as_float(w << 16); }
DI float bf_hi(unsigned w) { return __uint_as_float(w & 0xffff0000u); }
DI float bf2f(unsigned short h) { return __uint_as_float((unsigned)h << 16); }
DI void unpack8(const u32x4& w, float (&f)[8]) { f[0] = bf_lo(w.x); f[1] = bf_hi(w.x); f[2] = bf_lo(w.y); f[3] = bf_hi(w.y); f[4] = bf_lo(w.z); f[5] = bf_hi(w.z); f[6] = bf_lo(w.w); f[7] = bf_hi(w.w); }
DI u32x4 pack8(const float (&f)[8]) { u32x4 w; w.x = pk2(f[0], f[1]); w.y = pk2(f[2], f[3]); w.z = pk2(f[4], f[5]); w.w = pk2(f[6], f[7]); return w; }
template <int CTRL> DI float dppx(float v) { return __uint_as_float((unsigned)__builtin_amdgcn_update_dpp(0, (int)__float_as_uint(v), CTRL, 0xf, 0xf, true)); }
template <int PAT> DI float swz(float v) { return __uint_as_float((unsigned)__builtin_amdgcn_ds_swizzle((int)__float_as_uint(v), PAT)); }
DI float xor32_sum(float v) { const auto r = __builtin_amdgcn_permlane32_swap(__float_as_uint(v), __float_as_uint(v), false, false); return __uint_as_float(r[0]) + __uint_as_float(r[1]); }
DI float xor32_max(float v) { const auto r = __builtin_amdgcn_permlane32_swap(__float_as_uint(v), __float_as_uint(v), false, false); return fmaxf(__uint_as_float(r[0]), __uint_as_float(r[1])); }
DI float grp16_sum(float v) { v += dppx<0xB1>(v); v += dppx<0x4E>(v); v += dppx<0x141>(v); v += dppx<0x140>(v); return v; }
DI float wave_sum(float v) { v = grp16_sum(v); v += swz<0x401F>(v); return xor32_sum(v); }
template <int CTRL, int ROWMASK> DI float dppf(float oldv, float src) { return __uint_as_float((unsigned)__builtin_amdgcn_update_dpp((int)__float_as_uint(oldv), (int)__float_as_uint(src), CTRL, ROWMASK, 0xf, false)); }
DI float wave_scan_sum(float x) {
    x += dppf<0x111, 0xf>(0.f, x); x += dppf<0x112, 0xf>(0.f, x); x += dppf<0x114, 0xf>(0.f, x); x += dppf<0x118, 0xf>(0.f, x);
    x += dppf<0x142, 0xa>(0.f, x); x += dppf<0x143, 0xc>(0.f, x); return x; }
DI float wave_scan_max(float x) { const float ninf = -3.0e38f;
    x = fmaxf(x, dppf<0x111, 0xf>(ninf, x)); x = fmaxf(x, dppf<0x112, 0xf>(ninf, x)); x = fmaxf(x, dppf<0x114, 0xf>(ninf, x)); x = fmaxf(x, dppf<0x118, 0xf>(ninf, x));
    x = fmaxf(x, dppf<0x142, 0xa>(ninf, x)); x = fmaxf(x, dppf<0x143, 0xc>(ninf, x)); return x; }
DI int crow(int r, int hi) { return (r & 3) + 8 * (r >> 2) + 4 * hi; }
DI float fexp(float x) { return __builtin_amdgcn_exp2f(x * 1.4426950408889634f); }
DI float frcp(float x) { return __builtin_amdgcn_rcpf(x); }
DI float frsq(float x) { return __builtin_amdgcn_rsqf(x); }
DI float sigmoidf_(float x) { return frcp(1.0f + fexp(-x)); }
DI float siluf_(float x) { return x * frcp(1.0f + fexp(-x)); }
DI float log1p_(float t) { const float a = t * (1.0f - 0.5f * t), b = __builtin_amdgcn_logf(1.0f + t) * 0.6931471805599453f; return t < 1e-3f ? a : b; }
DI float logsigmoidf_(float x) { const float t = fexp(-fabsf(x)); return fminf(x, 0.f) - log1p_(t); }
#define MFMA32(a, b, c) __builtin_amdgcn_mfma_f32_32x32x16_bf16((a), (b), (c), 0, 0, 0)
DI bf16x8 cat4(s16x4 lo, s16x4 hi) { return __builtin_shufflevector(lo, hi, 0, 1, 2, 3, 4, 5, 6, 7); }
DI bf16x8 pack_step(const f32x16& x, int s) {
    u32x4 p; p.x = pk2(x[8 * s + 0], x[8 * s + 1]); p.y = pk2(x[8 * s + 2], x[8 * s + 3]); p.z = pk2(x[8 * s + 4], x[8 * s + 5]); p.w = pk2(x[8 * s + 6], x[8 * s + 7]);
    return __builtin_bit_cast(bf16x8, p);
}
DI void row_info(int row, int& b, int& t, int& T, int& v) {
    if (row < NCTX) { b = row >> 8; t = row & 255; T = 256; v = 0; } else { const int r = row - NCTX; b = r >> 10; t = r & 1023; T = 1024; v = 1 + b; }
}

struct EpiResid {
    static constexpr bool PERM = true, AFTER_DRAIN = false, ROWPERM = false;
    const void* base; int base_f32; bf16_t* out; const float* gate;
    __device__ __forceinline__ void operator()(const f32x4 (&acc)[2][2][4][2], const pg8::Unit& u, int wr, int wc, int fr, int fq) const {
        const int row0 = u.pm * 256 + wr * 64 + fr, col0 = u.pn * 256 + wc * 32 + 8 * fq;
        const int v = (u.pm < 32) ? 0 : 1 + ((u.pm - 32) >> 2);
        const float* gr = gate + (size_t)v * 12288;
        f32x4 g4[2][2];
#pragma unroll
        for (int bj = 0; bj < 2; ++bj)
#pragma unroll
            for (int n = 0; n < 2; ++n) g4[bj][n] = *(const f32x4*)(gr + col0 + bj * 128 + n * 4);
        if (base_f32) {
            const float* bf = (const float*)base;
#pragma unroll
            for (int am = 0; am < 8; ++am) {
                const int row = row0 + (am >> 2) * 128 + (am & 3) * 16; f32x4 bv[2][2];
#pragma unroll
                for (int bj = 0; bj < 2; ++bj)
#pragma unroll
                    for (int n = 0; n < 2; ++n) bv[bj][n] = *(const f32x4*)(bf + (size_t)row * DM + col0 + bj * 128 + n * 4);
#pragma unroll
                for (int bj = 0; bj < 2; ++bj) { const f32x4 y0 = bv[bj][0] + g4[bj][0] * acc[am >> 2][bj][am & 3][0], y1 = bv[bj][1] + g4[bj][1] * acc[am >> 2][bj][am & 3][1];
                    u32x4 w; w.x = pk2(y0.x, y0.y); w.y = pk2(y0.z, y0.w); w.z = pk2(y1.x, y1.y); w.w = pk2(y1.z, y1.w); *(u32x4*)(out + (size_t)row * DM + col0 + bj * 128) = w; }
            }
        } else {
            const bf16_t* bb = (const bf16_t*)base;
#pragma unroll
            for (int am = 0; am < 2; ++am) {
                u32x4 bv[4][2];
#pragma unroll
                for (int m = 0; m < 4; ++m)
#pragma unroll
                    for (int bj = 0; bj < 2; ++bj) bv[m][bj] = *(const u32x4*)(bb + (size_t)(row0 + am * 128 + m * 16) * DM + col0 + bj * 128);
#pragma unroll
                for (int m = 0; m < 4; ++m)
#pragma unroll
                    for (int bj = 0; bj < 2; ++bj) { float f[8]; unpack8(bv[m][bj], f); const f32x4 a0 = acc[am][bj][m][0], a1 = acc[am][bj][m][1];
                        f[0] += g4[bj][0].x * a0.x; f[1] += g4[bj][0].y * a0.y; f[2] += g4[bj][0].z * a0.z; f[3] += g4[bj][0].w * a0.w;
                        f[4] += g4[bj][1].x * a1.x; f[5] += g4[bj][1].y * a1.y; f[6] += g4[bj][1].z * a1.z; f[7] += g4[bj][1].w * a1.w;
                        *(u32x4*)(out + (size_t)(row0 + am * 128 + m * 16) * DM + col0 + bj * 128) = pack8(f); }
            }
        }
    }
};

struct EpiUp {
    static constexpr bool PERM = true, AFTER_DRAIN = false, ROWPERM = true;
    float* HALO; bf16_t* ACT; const float* cw; const float* cb; LAS float* xch;
    __device__ __forceinline__ void operator()(const f32x4 (&acc)[2][2][4][2], const pg8::Unit& u, int wr, int wc, int fr, int fq) const {
        const int tok0 = u.pm * 256 + 8 * (16 * wr + fr);
        const int ch0 = u.pn * 128 + wc * 32 + 8 * fq;
        f32x4 w0[2], w1[2], w2[2], bb[2];
#pragma unroll
        for (int bj = 0; bj < 2; ++bj) { const int cc = bj * DFF + ch0; w0[bj] = *(const f32x4*)(cw + cc); w1[bj] = *(const f32x4*)(cw + DFF2 + cc); w2[bj] = *(const f32x4*)(cw + 2 * DFF2 + cc); bb[bj] = *(const f32x4*)(cb + cc); }
        if (u.pm >= 32) {
            float* hb = HALO + (size_t)(u.pm - 32) * 8 * DFF + ch0;
            if (wr == 0 && fr == 0) {
#pragma unroll
                for (int r = 0; r < 2; ++r)
#pragma unroll
                    for (int bj = 0; bj < 2; ++bj)
#pragma unroll
                        for (int n = 0; n < 2; ++n) *(f32x4*)(hb + (size_t)(r * 2 + bj) * DFF + 4 * n) = acc[0][bj][r][n]; }
            if (wr == 1 && fr == 15) {
#pragma unroll
                for (int r = 2; r < 4; ++r)
#pragma unroll
                    for (int bj = 0; bj < 2; ++bj)
#pragma unroll
                        for (int n = 0; n < 2; ++n) *(f32x4*)(hb + (size_t)(r * 2 + bj) * DFF + 4 * n) = acc[1][bj][r][n]; }
        }
        float pv[2][8], nx[2][8];
#pragma unroll
        for (int bj = 0; bj < 2; ++bj)
#pragma unroll
            for (int c = 0; c < 8; ++c) { pv[bj][c] = dppx<0x111>(acc[1][bj][3][c >> 2][c & 3]); nx[bj][c] = dppx<0x101>(acc[0][bj][0][c >> 2][c & 3]);     }
        LAS f32x4* X = (LAS f32x4*)xch;
        if (fr == 0) { LAS f32x4* p = X + (((0 * 2 + wr) * 4 + wc) * 4 + fq) * 4; p[0] = acc[0][0][0][0]; p[1] = acc[0][0][0][1]; p[2] = acc[0][1][0][0]; p[3] = acc[0][1][0][1]; }
        if (fr == 15) { LAS f32x4* p = X + (((1 * 2 + wr) * 4 + wc) * 4 + fq) * 4; p[0] = acc[1][0][3][0]; p[1] = acc[1][0][3][1]; p[2] = acc[1][1][3][0]; p[3] = acc[1][1][3][1]; }
        asm volatile("s_waitcnt lgkmcnt(0)" ::: "memory"); __builtin_amdgcn_s_barrier(); asm volatile("" ::: "memory");
        if (fr == 0) {
            if (wr == 1) { const LAS f32x4* p = X + (((1 * 2 + 0) * 4 + wc) * 4 + fq) * 4; const f32x4 a = p[0], b = p[1], c = p[2], d = p[3];
                pv[0][0] = a[0]; pv[0][1] = a[1]; pv[0][2] = a[2]; pv[0][3] = a[3]; pv[0][4] = b[0]; pv[0][5] = b[1]; pv[0][6] = b[2]; pv[0][7] = b[3];
                pv[1][0] = c[0]; pv[1][1] = c[1]; pv[1][2] = c[2]; pv[1][3] = c[3]; pv[1][4] = d[0]; pv[1][5] = d[1]; pv[1][6] = d[2]; pv[1][7] = d[3]; }
            else {
#pragma unroll
                for (int c = 0; c < 8; ++c) { pv[0][c] = 0.f; pv[1][c] = 0.f; } }
        }
        if (fr == 15) {
            if (wr == 0) { const LAS f32x4* p = X + (((0 * 2 + 1) * 4 + wc) * 4 + fq) * 4; const f32x4 a = p[0], b = p[1], c = p[2], d = p[3];
                nx[0][0] = a[0]; nx[0][1] = a[1]; nx[0][2] = a[2]; nx[0][3] = a[3]; nx[0][4] = b[0]; nx[0][5] = b[1]; nx[0][6] = b[2]; nx[0][7] = b[3];
                nx[1][0] = c[0]; nx[1][1] = c[1]; nx[1][2] = c[2]; nx[1][3] = c[3]; nx[1][4] = d[0]; nx[1][5] = d[1]; nx[1][6] = d[2]; nx[1][7] = d[3]; }
            else {
#pragma unroll
                for (int c = 0; c < 8; ++c) { nx[0][c] = 0.f; nx[1][c] = 0.f; } }
        }
        u32x2 keep[8];
#pragma unroll
        for (int n = 0; n < 2; ++n) {
            if (n == 1) {
#pragma unroll
                for (int bj = 0; bj < 2; ++bj) { const int cc = bj * DFF + ch0 + 4; w0[bj] = *(const f32x4*)(cw + cc); w1[bj] = *(const f32x4*)(cw + DFF2 + cc); w2[bj] = *(const f32x4*)(cw + 2 * DFF2 + cc); bb[bj] = *(const f32x4*)(cb + cc); } }
#pragma unroll
            for (int k = 0; k < 8; ++k) {
                float y[4];
#pragma unroll
                for (int e = 0; e < 4; ++e) { const int c = 4 * n + e; float cv[2];
#pragma unroll
                    for (int bj = 0; bj < 2; ++bj) { const float xm = (k == 0) ? pv[bj][c] : acc[(k - 1) >> 2][bj][(k - 1) & 3][n][e], xc = acc[k >> 2][bj][k & 3][n][e], xp = (k == 7) ? nx[bj][c] : acc[(k + 1) >> 2][bj][(k + 1) & 3][n][e];
                        cv[bj] = bb[bj][e] + w0[bj][e] * xm + w1[bj][e] * xc + w2[bj][e] * xp; }
                    y[e] = siluf_(cv[0]) * cv[1]; }
                u32x2 w; w.x = pk2(y[0], y[1]); w.y = pk2(y[2], y[3]);
                if (n == 0) keep[k] = w; else *(u32x4*)(ACT + (size_t)(tok0 + k) * DFF + ch0) = (u32x4){keep[k].x, keep[k].y, w.x, w.y};
            }
        }
    }
};
struct EpiPart {
    static constexpr bool PERM = true, AFTER_DRAIN = false, ROWPERM = false;
    bf16_t* P;
    __device__ __forceinline__ void operator()(const f32x4 (&acc)[2][2][4][2], const pg8::Unit& u, int wr, int wc, int fr, int fq) const {
        const int row0 = u.pm * 256 + wr * 64 + fr, col0 = u.pn * 256 + wc * 32 + 8 * fq; bf16_t* base = P + (size_t)u.ks * NDEC * DM;
#pragma unroll
        for (int ai = 0; ai < 2; ++ai)
#pragma unroll
            for (int m = 0; m < 4; ++m) { bf16_t* op = base + (size_t)(row0 + ai * 128 + m * 16) * DM;
#pragma unroll
                for (int bj = 0; bj < 2; ++bj) { const f32x4 a = acc[ai][bj][m][0], c = acc[ai][bj][m][1]; u32x4 w; w.x = pk2(a.x, a.y); w.y = pk2(a.z, a.w); w.z = pk2(c.x, c.y); w.w = pk2(c.z, c.w); *(u32x4*)(op + col0 + bj * 128) = w; } }
    }
};
struct OutOrder {
    int G, c, Kq;
    __device__ __forceinline__ bool next(int i, pg8::Unit& u) const {
        int J;
        if (G == 256) { if (i >= 2) return false; J = (i == 0) ? c : 256 + c; }
        else { J = i * G + c; if (J >= 512) return false; }
        const int L = J & 255; const bool lat = J >= 256;
        const int w = (L & 7) * 32 + (L >> 3);
        u.pm = lat ? 32 + (L >> 5) : (w >> 6) * 8 + (w & 7); u.pn = lat ? (L >> 2) & 7 : (w & 63) >> 3; u.ks = lat ? L & 3 : 0; u.koff = lat ? (L & 3) * Kq : 0; return true;
    }
    __device__ __forceinline__ void a_ready(const pg8::Unit&) const {}
    __device__ __forceinline__ void done(const pg8::Unit&) const {}
    __device__ __forceinline__ int unit_nt(const pg8::Unit& u, int nt_gemm) const { return u.pm >= 32 ? Kq / pg8::BK : nt_gemm; }
    __device__ __forceinline__ int latent_of(int i) const { if (G == 256) return i == 1 ? c : -1; const int J = i * G + c; return (J >= 256 && J < 512) ? J - 256 : -1; }
};
DI void ffn_edge_fix(int L, const float* HALO, const float* cw, const float* cb, bf16_t* ACT, int tid) {
    const int pt = L >> 5, ks = L & 3, q = pt & 3;
    for (int idx = tid; idx < 2 * (DFF / 4); idx += NTHR) {
        const int side = idx >= DFF / 4 ? 1 : 0, ch = ks * (DFF / 4) + idx - side * (DFF / 4);
        if (side ? (q == 3) : (q == 0)) continue;
        const float* hm = HALO + (size_t)(side ? pt * 4 + 2 : (pt - 1) * 4 + 3) * 2 * DFF + ch;
        const float* hc = HALO + (size_t)(side ? pt * 4 + 3 : pt * 4 + 0) * 2 * DFF + ch;
        const float* hp = HALO + (size_t)(side ? (pt + 1) * 4 + 0 : pt * 4 + 1) * 2 * DFF + ch;
        float cv[2];
#pragma unroll
        for (int bj = 0; bj < 2; ++bj) { const int cc = bj * DFF + ch; cv[bj] = cb[cc] + cw[cc] * hm[bj * DFF] + cw[DFF2 + cc] * hc[bj * DFF] + cw[2 * DFF2 + cc] * hp[bj * DFF]; }
        const float y = siluf_(cv[0]) * cv[1];
        ACT[(size_t)(NCTX + pt * 256 + (side ? 255 : 0)) * DFF + ch] = (bf16_t)(pk2(y, y) & 0xffffu);
    }
}
struct EpiResPart {
    static constexpr bool PERM = true, AFTER_DRAIN = false, ROWPERM = false;
    EpiResid R; EpiPart Pq;
    __device__ __forceinline__ void operator()(const f32x4 (&acc)[2][2][4][2], const pg8::Unit& u, int wr, int wc, int fr, int fq) const {
        if (u.pm < 32) R(acc, u, wr, wc, fr, fq);
        else Pq(acc, u, wr, wc, fr, fq);
    }
};

struct InOrder {
    pg8::StaticOrder S0; int G, c, nW, nQ;
    __device__ __forceinline__ bool next(int i, pg8::Unit& u) const {
        pg8::Unit t; const bool w = S0.next(i, t); const int q = i * G + c - nW;
        if (!w && q >= nQ) return false;
        u.pm = w ? t.pm : q >> 2; u.pn = w ? t.pn : S0.nN; u.ks = w ? 0 : q & 3; u.koff = w ? 0 : (q & 3) * 512; return true;
    }
    __device__ __forceinline__ void a_ready(const pg8::Unit&) const {}
    __device__ __forceinline__ void done(const pg8::Unit&) const {}
    __device__ __forceinline__ int unit_nt(const pg8::Unit& u, int nt_gemm) const { return u.pn >= S0.nN ? 512 / pg8::BK : nt_gemm; }
};
struct EpiInQ {
    static constexpr bool PERM = true, AFTER_DRAIN = false, ROWPERM = false;
    pg8::EpiBf16<0> E0; bf16_t* P2; int npw;
    __device__ __forceinline__ void operator()(const f32x4 (&acc)[2][2][4][2], const pg8::Unit& u, int wr, int wc, int fr, int fq) const {
        if (u.pn < npw) { E0(acc, u, wr, wc, fr, fq); return; }
        bf16_t* base = P2 + ((size_t)u.ks * MTOK + u.pm * 256 + wr * 64 + fr) * 128 + wc * 32 + 8 * fq;
#pragma unroll
        for (int ai = 0; ai < 2; ++ai)
#pragma unroll
            for (int m = 0; m < 4; ++m) { const f32x4 v0 = acc[ai][0][m][0], v1 = acc[ai][0][m][1]; u32x4 w; w.x = pk2(v0[0], v0[1]); w.y = pk2(v0[2], v0[3]); w.z = pk2(v1[0], v1[1]); w.w = pk2(v1[2], v1[3]);
                *(u32x4*)(base + (size_t)(ai * 128 + m * 16) * 128) = w; }
    }
};

DI void p0_tr64(const float* W, int K, int N, bf16_t* WT, int item, int lane, int perm, LAS unsigned char* lw) {
    const int nblk = (N + 127) >> 7, gpr = (nblk + 1) >> 1, g4 = item >> 2, e4 = item & 3, kb = 2 * (g4 / gpr) + (e4 >> 1), nb = 2 * (g4 % gpr) + (e4 & 1), k0 = kb * 64, n = nb * 128 + 2 * lane;
    if (nb >= nblk) return;
    const float* p = W + (size_t)k0 * N + ((n < N) ? n : 0);
    f32x2 v[64];
#pragma unroll
    for (int i = 0; i < 64; ++i) v[i] = *(const f32x2*)(p + (size_t)i * N);
#pragma unroll
    for (int q = 0; q < 2; ++q)
#pragma unroll
        for (int c = 0; c < 8; ++c) { u32x4 o; o.x = pk2(v[8 * c][q], v[8 * c + 1][q]); o.y = pk2(v[8 * c + 2][q], v[8 * c + 3][q]); o.z = pk2(v[8 * c + 4][q], v[8 * c + 5][q]); o.w = pk2(v[8 * c + 6][q], v[8 * c + 7][q]);
            *(LAS u32x4*)(lw + (2 * lane + q) * 144 + c * 16) = o; }
#pragma unroll
    for (int i = 0; i < 16; ++i) { const int r = 8 * i + (lane >> 3), nn = nb * 128 + r; const u32x4 o = *(const LAS u32x4*)(lw + r * 144 + (lane & 7) * 16);
        const int half = (nn >= DFF) ? 1 : 0, ch = nn - half * DFF, nrow = (perm == 1) ? ((ch >> 7) * 256 + half * 128 + (ch & 127)) : (perm == 2) ? (nn < 4096 ? nn : (nn < 4128 ? nn + 832 : nn - 32)) : nn;
        if (nn < N) *(u32x4*)(WT + (size_t)nrow * K + k0 + (lane & 7) * 8) = o; }
}
DI void rope_table_entry(float* tab, int i) {
    const int pos = i >> 5, k = i & 31;
    const float invf = __builtin_amdgcn_exp2f(-(float)k * (13.287712379549449f / 32.0f));
    const double a = (double)invf, a2 = a * a;
    double c = 1.0, s = a, tc = 1.0, ts = a;
#pragma unroll
    for (int n = 1; n <= 11; ++n) { tc *= -a2 / (double)((2 * n - 1) * (2 * n)); ts *= -a2 / (double)((2 * n) * (2 * n + 1)); c += tc; s += ts; }
    double cr = 1.0, sr = 0.0;
    for (int p = 0; p < pos; ++p) { const double cn = cr * c - sr * s, sn = cr * s + sr * c; cr = cn; sr = sn; }
    tab[2 * i] = (float)cr; tab[2 * i + 1] = (float)sr;
}

DI void row_sum_partials(const u32x4 (&q)[4], float (&p)[8]) { float a[8], b[8], c[8], d[8]; unpack8(q[0], a); unpack8(q[1], b); unpack8(q[2], c); unpack8(q[3], d);
#pragma unroll
    for (int e = 0; e < 8; ++e) p[e] = (a[e] + b[e]) + (c[e] + d[e]); }
DI void norm_mod_rows(const void* xc, int cf32, const void* xd, int df32, const float* g, const float* mod, int which, bf16_t* H, const float* fixg, const bf16_t* P, bf16_t* Xw, int gw, int ngw, int lane) {
    for (int row = gw; row < MTOK; row += ngw) {
        const bool dec = row >= NCTX; const int rr = dec ? row - NCTX : row;
        const int v = dec ? 1 + (rr >> 10) : 0;
        const float* sh = mod + (size_t)v * 12288 + which * 2048;
        float x[4][8];
        if (dec ? df32 : cf32) { const float* xr = (const float*)(dec ? xd : xc) + (size_t)rr * DM; f32x4 ra[4], rb[4];
#pragma unroll
            for (int jj = 0; jj < 4; ++jj) { ra[jj] = *(const f32x4*)(xr + (lane + 64 * jj) * 8); rb[jj] = *(const f32x4*)(xr + (lane + 64 * jj) * 8 + 4); }
#pragma unroll
            for (int jj = 0; jj < 4; ++jj) { x[jj][0] = ra[jj].x; x[jj][1] = ra[jj].y; x[jj][2] = ra[jj].z; x[jj][3] = ra[jj].w; x[jj][4] = rb[jj].x; x[jj][5] = rb[jj].y; x[jj][6] = rb[jj].z; x[jj][7] = rb[jj].w; }
        } else { const bf16_t* xr = (const bf16_t*)(dec ? xd : xc) + (size_t)rr * DM; u32x4 rw[4];
#pragma unroll
            for (int jj = 0; jj < 4; ++jj) rw[jj] = *(const u32x4*)(xr + (lane + 64 * jj) * 8);
#pragma unroll
            for (int jj = 0; jj < 4; ++jj) unpack8(rw[jj], x[jj]);
        }
        const bool fix = dec && fixg;
        if (fix) {
            const bf16_t* pr = P + (size_t)rr * DM; const float* fg = fixg + (size_t)v * 12288;
            u32x4 q[4][4]; f32x4 fa[4], fb[4];
#pragma unroll
            for (int jj = 0; jj < 4; ++jj) { const int c = (lane + 64 * jj) * 8;
#pragma unroll
                for (int k = 0; k < 4; ++k) q[jj][k] = *(const u32x4*)(pr + (size_t)k * NDEC * DM + c);
                fa[jj] = *(const f32x4*)(fg + c); fb[jj] = *(const f32x4*)(fg + c + 4); }
#pragma unroll
            for (int jj = 0; jj < 4; ++jj) { float p[8]; row_sum_partials(q[jj], p);
                x[jj][0] += fa[jj].x * p[0]; x[jj][1] += fa[jj].y * p[1]; x[jj][2] += fa[jj].z * p[2]; x[jj][3] += fa[jj].w * p[3];
                x[jj][4] += fb[jj].x * p[4]; x[jj][5] += fb[jj].y * p[5]; x[jj][6] += fb[jj].z * p[6]; x[jj][7] += fb[jj].w * p[7]; }
        }
        f32x4 ga[4], gb[4], sfa[4], sfb[4], sca[4], scb[4];
#pragma unroll
        for (int jj = 0; jj < 4; ++jj) { const int c = (lane + 64 * jj) * 8; ga[jj] = *(const f32x4*)(g + c); gb[jj] = *(const f32x4*)(g + c + 4); sfa[jj] = *(const f32x4*)(sh + c); sfb[jj] = *(const f32x4*)(sh + c + 4);
            sca[jj] = *(const f32x4*)(sh + 2048 + c); scb[jj] = *(const f32x4*)(sh + 2048 + c + 4); }
        if (fix) {
#pragma unroll
            for (int jj = 0; jj < 4; ++jj) *(u32x4*)(Xw + (size_t)row * DM + (lane + 64 * jj) * 8) = pack8(x[jj]);
        }
        float ss = 0.f;
#pragma unroll
        for (int jj = 0; jj < 4; ++jj)
#pragma unroll
            for (int e = 0; e < 8; ++e) ss += x[jj][e] * x[jj][e];
        ss = wave_sum(ss);
        const float rstd = frsq(ss * (1.0f / DM) + EPS);
        u32x4 o[4];
#pragma unroll
        for (int jj = 0; jj < 4; ++jj) { float y[8];
#pragma unroll
            for (int e = 0; e < 4; ++e) { y[e] = x[jj][e] * rstd * ga[jj][e] * (sca[jj][e] + 1.0f) + sfa[jj][e]; y[4 + e] = x[jj][4 + e] * rstd * gb[jj][e] * (scb[jj][e] + 1.0f) + sfb[jj][e]; }
            o[jj] = pack8(y); }
#pragma unroll
        for (int jj = 0; jj < 4; ++jj) *(u32x4*)(H + (size_t)row * DM + (lane + 64 * jj) * 8) = o[jj];
    }
}
DI void final_norm_rows(const bf16_t* X, const float* g, float* out, const float* fixg, const bf16_t* P, int gw, int ngw, int lane) {
    for (int row = gw; row < MTOK; row += ngw) {
        const bf16_t* xr = X + (size_t)row * DM; u32x4 rw[4]; float x[4][8];
#pragma unroll
        for (int jj = 0; jj < 4; ++jj) rw[jj] = *(const u32x4*)(xr + (lane + 64 * jj) * 8);
#pragma unroll
        for (int jj = 0; jj < 4; ++jj) unpack8(rw[jj], x[jj]);
        if (row >= NCTX) { const int rr = row - NCTX, v = 1 + (rr >> 10); const bf16_t* pr = P + (size_t)rr * DM; const float* fg = fixg + (size_t)v * 12288;
            u32x4 q[4][4]; f32x4 fa[4], fb[4];
#pragma unroll
            for (int jj = 0; jj < 4; ++jj) { const int c = (lane + 64 * jj) * 8;
#pragma unroll
                for (int k = 0; k < 4; ++k) q[jj][k] = *(const u32x4*)(pr + (size_t)k * NDEC * DM + c);
                fa[jj] = *(const f32x4*)(fg + c); fb[jj] = *(const f32x4*)(fg + c + 4); }
#pragma unroll
            for (int jj = 0; jj < 4; ++jj) { float p[8]; row_sum_partials(q[jj], p);
                x[jj][0] += fa[jj].x * p[0]; x[jj][1] += fa[jj].y * p[1]; x[jj][2] += fa[jj].z * p[2]; x[jj][3] += fa[jj].w * p[3];
                x[jj][4] += fb[jj].x * p[4]; x[jj][5] += fb[jj].y * p[5]; x[jj][6] += fb[jj].z * p[6]; x[jj][7] += fb[jj].w * p[7]; } }
        float ss = 0.f;
#pragma unroll
        for (int jj = 0; jj < 4; ++jj)
#pragma unroll
            for (int e = 0; e < 8; ++e) ss += x[jj][e] * x[jj][e];
        ss = wave_sum(ss);
        const float rstd = frsq(ss * (1.0f / DM) + EPS);
#pragma unroll
        for (int jj = 0; jj < 4; ++jj) { const int c = (lane + 64 * jj) * 8; const f32x4 g0 = *(const f32x4*)(g + c), g1 = *(const f32x4*)(g + c + 4);
            *(f32x4*)(out + (size_t)row * DM + c) = (f32x4){x[jj][0] * rstd * g0.x, x[jj][1] * rstd * g0.y, x[jj][2] * rstd * g0.z, x[jj][3] * rstd * g0.w};
            *(f32x4*)(out + (size_t)row * DM + c + 4) = (f32x4){x[jj][4] * rstd * g1.x, x[jj][5] * rstd * g1.y, x[jj][6] * rstd * g1.z, x[jj][7] * rstd * g1.w}; }
    }
}

template <int DIMQ> DI void rope_chunk(float (&f)[8], int ci, const float* tab, int pr, int pc) {
    constexpr int CPQ = DIMQ / 8;
    const bool x2 = (ci & CPQ) != 0; const int part = ci / (2 * CPQ); const int iq0 = (ci & (CPQ - 1)) * 8;
    const int pos = part ? pc : pr;
    float p[8];
#pragma unroll
    for (int e = 0; e < 8; ++e) { if constexpr (CPQ == 2) p[e] = dppx<0x4E>(f[e]); else p[e] = swz<0x101F>(f[e]); }
#pragma unroll
    for (int e = 0; e < 8; ++e) { const int k = (DIMQ == 16) ? 2 * (iq0 + e) : (iq0 + e); const f32x2 cs = *(const f32x2*)(tab + (size_t)(pos * 32 + k) * 2);
        f[e] = x2 ? (p[e] * cs.y + f[e] * cs.x) : (f[e] * cs.x - p[e] * cs.y); }
}
DI void transpose64_bf16(const bf16_t* srow, bf16_t* dst, size_t ld) {
#pragma unroll
    for (int ch = 0; ch < 8; ++ch) { const u32x4 w = *(const u32x4*)(srow + ch * 8);
#pragma unroll
        for (int e = 0; e < 8; ++e) { const unsigned ww = w[e >> 1]; dst[(size_t)(ch * 8 + e) * ld] = (bf16_t)((e & 1) ? (ww >> 16) : (ww & 0xffffu)); } }
}
DI void transpose64_f32(const float* srow, bf16_t* dst, size_t ld) {
#pragma unroll
    for (int ch = 0; ch < 8; ++ch) { const f32x4 a = *(const f32x4*)(srow + ch * 8), b = *(const f32x4*)(srow + ch * 8 + 4);
        const unsigned w0 = pk2(a.x, a.y), w1 = pk2(a.z, a.w), w2 = pk2(b.x, b.y), w3 = pk2(b.z, b.w);
        dst[(size_t)(ch * 8 + 0) * ld] = (bf16_t)(w0 & 0xffffu); dst[(size_t)(ch * 8 + 1) * ld] = (bf16_t)(w0 >> 16);
        dst[(size_t)(ch * 8 + 2) * ld] = (bf16_t)(w1 & 0xffffu); dst[(size_t)(ch * 8 + 3) * ld] = (bf16_t)(w1 >> 16);
        dst[(size_t)(ch * 8 + 4) * ld] = (bf16_t)(w2 & 0xffffu); dst[(size_t)(ch * 8 + 5) * ld] = (bf16_t)(w2 >> 16);
        dst[(size_t)(ch * 8 + 6) * ld] = (bf16_t)(w3 & 0xffffu); dst[(size_t)(ch * 8 + 7) * ld] = (bf16_t)(w3 >> 16); }
}
#define XB_TMO      128
#define XB_XCNT(j)  (256  + 64 * (j))
#define XB_XSUB(j)  (1280 + 64 * (j))
#define XB_XGEN(j)  (2304 + 64 * (j))
#define XB_TOP      3328
#define XB_TOPGEN   3392
#define XCD_BAR_WORDS 3456
#define XB_SPIN_CAP (1u << 22)

__device__ __forceinline__ unsigned xb_ld(unsigned* p)              { return __hip_atomic_load(p, __ATOMIC_RELAXED, __HIP_MEMORY_SCOPE_AGENT); }
__device__ __forceinline__ unsigned xb_add(unsigned* p, unsigned v) { return __hip_atomic_fetch_add(p, v, __ATOMIC_RELAXED, __HIP_MEMORY_SCOPE_AGENT); }
__device__ __forceinline__ unsigned xb_xcc_id() { return (unsigned)__builtin_amdgcn_s_getreg((3 << 11) | 20) & 0xFu; }
#define XB_SPIN(cond, bar) do { unsigned _sp = 0; while (cond) { __builtin_amdgcn_s_sleep(1); \
    if ((++_sp & 255u) == 0u) { if (xb_ld(&(bar)[XB_TMO])) break; if (_sp > XB_SPIN_CAP) { atomicAdd(&(bar)[XB_TMO], 1u); break; } } } } while (0)

struct XcdBarrier {
    unsigned* bar; unsigned x;
    volatile LAS unsigned* st;
};

__device__ __forceinline__ XcdBarrier xcd_barrier_post(unsigned* bar, volatile LAS unsigned* st) {
    XcdBarrier b; b.bar = bar; b.x = (unsigned)__builtin_amdgcn_readfirstlane((int)xb_xcc_id()); b.st = st;
    if (threadIdx.x == 0) (void)xb_add(&bar[XB_XCNT(b.x)], 1u);
    return b;
}
__device__ __forceinline__ void xcd_barrier_complete(unsigned* bar, unsigned x, unsigned& nloc, unsigned& nx) {
    const unsigned G = gridDim.x * gridDim.y * gridDim.z;
    unsigned sum, cnt, mine, sp = 0u;
    for (;;) {
        sum = 0u; cnt = 0u; mine = 0u;
#pragma unroll
        for (unsigned j = 0; j < 16; ++j) { const unsigned c = xb_ld(&bar[XB_XCNT(j)]); sum += c; cnt += (c > 0u) ? 1u : 0u; mine = (j == x) ? c : mine; }
        if (sum == G) break;
        __builtin_amdgcn_s_sleep(1);
        if ((++sp & 255u) == 0u) { if (xb_ld(&bar[XB_TMO])) break; if (sp > XB_SPIN_CAP) { atomicAdd(&bar[XB_TMO], 1u); break; } }
    }
    nloc = mine > 0u ? mine : 1u; nx = cnt > 0u ? cnt : 1u;
}

__device__ __forceinline__ void xcd_barrier(const XcdBarrier& b, const int tid_) {
    asm volatile("s_waitcnt vmcnt(0)" ::: "memory");
    __syncthreads();
    if (tid_ == 0) {
        unsigned* bar = b.bar; unsigned bx = b.x; asm volatile("" : "+s"(bar), "+s"(bx));
        __builtin_amdgcn_s_waitcnt(0);
        unsigned nloc = b.st[0], nx = b.st[1];
        if (nloc == 0u) { xcd_barrier_complete(bar, bx, nloc, nx); b.st[0] = nloc; b.st[1] = nx; }
        const unsigned old = xb_add(&bar[XB_XSUB(bx)], 1u);
        const unsigned gen = old / nloc;
        if (old + 1u == (gen + 1u) * nloc) {
            __builtin_amdgcn_fence(__ATOMIC_RELEASE, "agent");
            asm volatile("s_waitcnt vmcnt(0)" ::: "memory");
            const unsigned og = xb_add(&bar[XB_TOP], 1u);
            const unsigned tg = og / nx;
            if (og + 1u == (tg + 1u) * nx) {
#pragma unroll
                for (unsigned j = 0; j < 16; ++j) xb_add(&bar[XB_XGEN(j)], 1u);
                __builtin_amdgcn_fence(__ATOMIC_ACQUIRE, "agent");
            } else { __builtin_amdgcn_fence(__ATOMIC_ACQUIRE, "agent");
                   XB_SPIN(xb_ld(&bar[XB_XGEN(bx)]) == gen, bar); }
            asm volatile("s_waitcnt vmcnt(0)" ::: "memory");
        } else {
            __builtin_amdgcn_fence(__ATOMIC_ACQUIRE, "agent");
            XB_SPIN(xb_ld(&bar[XB_XGEN(bx)]) == gen, bar);
            asm volatile("s_waitcnt vmcnt(0)" ::: "memory");
        }
    }
    __syncthreads();
}

__device__ __forceinline__ void xcd_barrier_fast(const XcdBarrier& b, const int tid_) {
    asm volatile("s_waitcnt vmcnt(0)" ::: "memory");
    __syncthreads();
    if (tid_ == 0) {
        unsigned* bar = b.bar; unsigned bx = b.x; asm volatile("" : "+s"(bar), "+s"(bx));
        __builtin_amdgcn_s_waitcnt(0);
        unsigned nloc = b.st[0], nx = b.st[1];
        const unsigned old = xb_add(&bar[XB_XSUB(bx)], 1u);
        const unsigned gen = old / nloc;
        if (old + 1u == (gen + 1u) * nloc) {
            __builtin_amdgcn_fence(__ATOMIC_RELEASE, "agent");
            asm volatile("s_waitcnt vmcnt(0)" ::: "memory");
            const unsigned og = xb_add(&bar[XB_TOP], 1u);
            const unsigned tg = og / nx;
            if (og + 1u == (tg + 1u) * nx) {
#pragma unroll
                for (unsigned j = 0; j < 16; ++j) xb_add(&bar[XB_XGEN(j)], 1u);
                __builtin_amdgcn_fence(__ATOMIC_ACQUIRE, "agent");
            } else { __builtin_amdgcn_fence(__ATOMIC_ACQUIRE, "agent");
                   XB_SPIN(xb_ld(&bar[XB_XGEN(bx)]) == gen, bar); }
            asm volatile("s_waitcnt vmcnt(0)" ::: "memory");
        } else {
            __builtin_amdgcn_fence(__ATOMIC_ACQUIRE, "agent");
            XB_SPIN(xb_ld(&bar[XB_XGEN(bx)]) == gen, bar);
            asm volatile("s_waitcnt vmcnt(0)" ::: "memory");
        }
    }
    __syncthreads();
}
DI void epost_row(bf16_t* raw, int row, int j, float* out, const float* qng, const float* kng, bf16_t* KAd, bf16_t* KBd, bf16_t* VAd, bf16_t* VBd, const float* tab, int lane) {
    int b, t, T, v; row_info(row, b, t, T, v); const bool dec = row >= NCTX; const int pr = t >> 6, pc = t & 63;
    bf16_t* rp = raw + (size_t)row * EVEN_IN;
    u32x4 wall[9];
#pragma unroll
    for (int it = 0; it < 9; ++it) wall[it] = (it < 2 || it == 6 || it == 7) ? (u32x4){0u, 0u, 0u, 0u} : *(const u32x4*)(rp + (it * 64 + lane) * 8);
#pragma unroll
    for (int it = 0; it < 9; ++it) {
        const int c0 = (it * 64 + lane) * 8;
        if (it < 2 || it == 6 || it == 7) continue;
        const u32x4 w = wall[it]; float f[8]; unpack8(w, f);
        if (it < 2) {
            rope_chunk<16>(f, (c0 >> 3) & 7, tab, pr, pc); *(u32x4*)(rp + c0) = pack8(f);
        } else if (it < 4) {
            const int cc = c0 - 1024, h = cc >> 7, c2 = (cc >> 6) & 1, d = cc & 63;
            if (!dec) { float* o = out + O_DAK + ((((size_t)(b * 2 + j) * 8 + h) * 2 + c2) * 256 + t) * 64 + d;
                *(f32x4*)o = (f32x4){f[0], f[1], f[2], f[3]}; *(f32x4*)(o + 4) = (f32x4){f[4], f[5], f[6], f[7]}; }
            else { rope_chunk<16>(f, (c0 >> 3) & 7, tab, pr, pc); *(u32x4*)(KAd + ((size_t)(b * 1280 + 256 + t)) * 1024 + cc) = pack8(f); }
        } else if (it < 6) {
            const int cc = c0 - 2048, h = cc >> 7, d = cc & 127;
            if (!dec) { float* o = out + O_DAV + (((size_t)(b * 2 + j) * 8 + h) * 256 + t) * 128 + d;
                *(f32x4*)o = (f32x4){f[0], f[1], f[2], f[3]}; *(f32x4*)(o + 4) = (f32x4){f[4], f[5], f[6], f[7]}; }
            else *(u32x4*)(VAd + ((size_t)(b * 1280 + 256 + t)) * 1024 + cc) = w;
        } else if (it < 8) {
            const int d = c0 & 127; float ss = 0.f;
#pragma unroll
            for (int e = 0; e < 8; ++e) ss += f[e] * f[e];
            ss = grp16_sum(ss); const float rstd = frsq(ss * (1.0f / 128.0f) + EPS);
#pragma unroll
            for (int e = 0; e < 8; ++e) f[e] = f[e] * rstd * qng[d + e];
            if (dec) rope_chunk<32>(f, (c0 >> 3) & 15, tab, pr, pc);
            *(u32x4*)(rp + c0) = pack8(f);
        } else {
            const bool iskb = lane < 32; const int cc = iskb ? c0 - 4096 : c0 - 4352, g = cc >> 7, d = cc & 127;
            float ss = 0.f;
#pragma unroll
            for (int e = 0; e < 8; ++e) ss += f[e] * f[e];
            ss = grp16_sum(ss); const float rstd = frsq(ss * (1.0f / 128.0f) + EPS);
            float fk[8];
#pragma unroll
            for (int e = 0; e < 8; ++e) fk[e] = f[e] * rstd * kng[d + e];
            if (dec) rope_chunk<32>(fk, (c0 >> 3) & 15, tab, pr, pc);
            if (iskb) {
                if (!dec) { *(u32x4*)(rp + c0) = pack8(fk); float* o = out + O_GQK + (((size_t)(b * 2 + j) * 2 + g) * 256 + t) * 128 + d;
                    *(f32x4*)o = (f32x4){fk[0], fk[1], fk[2], fk[3]}; *(f32x4*)(o + 4) = (f32x4){fk[4], fk[5], fk[6], fk[7]}; }
                else *(u32x4*)(KBd + ((size_t)(b * 1280 + 256 + t)) * 256 + cc) = pack8(fk);
            } else if (!dec) { float* o = out + O_GQV + (((size_t)(b * 2 + j) * 2 + g) * 256 + t) * 128 + d;
                *(f32x4*)o = (f32x4){f[0], f[1], f[2], f[3]}; *(f32x4*)(o + 4) = (f32x4){f[4], f[5], f[6], f[7]}; }
            else *(u32x4*)(VBd + ((size_t)(b * 1280 + 256 + t)) * 256 + cc) = w;
        }
    }
}
DI void epost_cache(int item, int j, const float* cdak, const float* cdav, const float* cgqk, const float* cgqv, bf16_t* KAd, bf16_t* KBd, bf16_t* VAd, bf16_t* VBd, int lane) {
    const int b = item >> 8, s = item & 255;
#pragma unroll
    for (int it = 0; it < 2; ++it) { const int col = (it * 64 + lane) * 8, h = col >> 7, c2 = (col >> 6) & 1, d = col & 63;
        const float* src = cdak + ((((size_t)(b * 2 + j) * 8 + h) * 2 + c2) * 256 + s) * 64 + d;
        const f32x4 a = *(const f32x4*)src, bb = *(const f32x4*)(src + 4); u32x4 w; w.x = pk2(a.x, a.y); w.y = pk2(a.z, a.w); w.z = pk2(bb.x, bb.y); w.w = pk2(bb.z, bb.w);
        *(u32x4*)(KAd + ((size_t)(b * 1280 + s)) * 1024 + col) = w;
        const float* sv = cdav + (((size_t)(b * 2 + j) * 8 + h) * 256 + s) * 128 + (col & 127);
        const f32x4 va = *(const f32x4*)sv, vb = *(const f32x4*)(sv + 4); u32x4 wv; wv.x = pk2(va.x, va.y); wv.y = pk2(va.z, va.w); wv.z = pk2(vb.x, vb.y); wv.w = pk2(vb.z, vb.w);
        *(u32x4*)(VAd + ((size_t)(b * 1280 + s)) * 1024 + col) = wv; }
    if (lane < 32) { const int col = lane * 8, g = col >> 7, d = col & 127;
        const float* src = cgqk + (((size_t)(b * 2 + j) * 2 + g) * 256 + s) * 128 + d;
        const f32x4 a = *(const f32x4*)src, bb = *(const f32x4*)(src + 4); u32x4 w; w.x = pk2(a.x, a.y); w.y = pk2(a.z, a.w); w.z = pk2(bb.x, bb.y); w.w = pk2(bb.z, bb.w);
        *(u32x4*)(KBd + ((size_t)(b * 1280 + s)) * 256 + col) = w;
        const float* sv = cgqv + (((size_t)(b * 2 + j) * 2 + g) * 256 + s) * 128 + d;
        const f32x4 va = *(const f32x4*)sv, vb = *(const f32x4*)(sv + 4); u32x4 wv; wv.x = pk2(va.x, va.y); wv.y = pk2(va.z, va.w); wv.z = pk2(vb.x, vb.y); wv.w = pk2(vb.z, vb.w);
        *(u32x4*)(VBd + ((size_t)(b * 1280 + s)) * 256 + col) = wv; }
}

template <int NDQ, int NDA>
DI void attn_wg(const bf16_t* Q, int ldq, const bf16_t* K, int ldk, const bf16_t* K2, int ldk2, int nkeys, const bf16_t* V, int ldv, float C, f32x16 (&o)[4], float& l_out, LAS unsigned char* lds, int tid, const float* rtab = nullptr, int rt0 = 0, const float* qgain = nullptr) {
    constexpr int ROWK = NDQ * 32 + 16, KB = 64 * ROWK, VB = 128 * 136, BUF = KB + VB, NKC = NDQ / 4;
    const int lane = tid & 63, wave = __builtin_amdgcn_readfirstlane(tid >> 6), r32 = lane & 31, hi = lane >> 5;
    bf16x8 qr[NDQ];
#pragma unroll
    for (int d0 = 0; d0 < NDQ; ++d0) qr[d0] = *(const bf16x8*)(Q + (size_t)(wave * 32 + r32) * ldq + d0 * 16 + hi * 8);
    if constexpr (NDQ == 8) { if (qgain) {
        float ss = 0.f;
#pragma unroll
        for (int d0 = 0; d0 < 8; ++d0) { float f[8]; unpack8(__builtin_bit_cast(u32x4, qr[d0]), f);
#pragma unroll
            for (int e = 0; e < 8; ++e) ss += f[e] * f[e]; }
        ss = xor32_sum(ss); const float rstd = frsq(ss * (1.0f / 128.0f) + EPS);
        const int t = rt0 + wave * 32 + r32, pr = t >> 6, pc = t & 63;
#pragma unroll
        for (int pp = 0; pp < 2; ++pp)
#pragma unroll
            for (int dd = 0; dd < 2; ++dd) { const int pos = pp ? pc : pr, da = 4 * pp + dd, db = da + 2;
                float x1[8], x2[8]; unpack8(__builtin_bit_cast(u32x4, qr[da]), x1); unpack8(__builtin_bit_cast(u32x4, qr[db]), x2);
                const float* ga = qgain + da * 16 + hi * 8; const float* gb = ga + 32;
#pragma unroll
                for (int e = 0; e < 8; ++e) { x1[e] *= rstd * ga[e]; x2[e] *= rstd * gb[e]; }
                if (rtab) {
#pragma unroll
                    for (int e = 0; e < 8; ++e) { const f32x2 cs = *(const f32x2*)(rtab + (size_t)(pos * 32 + (dd * 2 + hi) * 8 + e) * 2); const float a = x1[e] * cs.x - x2[e] * cs.y, b2 = x1[e] * cs.y + x2[e] * cs.x; x1[e] = a; x2[e] = b2; } }
                qr[da] = __builtin_bit_cast(bf16x8, pack8(x1)); qr[db] = __builtin_bit_cast(bf16x8, pack8(x2));
                __builtin_amdgcn_sched_barrier(0);
            }
    } }
    if constexpr (NDQ == 12 || NDQ == 4) { if (rtab) {
        constexpr int qb0 = (NDQ == 12) ? 8 : 0;
        const int t = rt0 + wave * 32 + r32, pr = t >> 6, pc = t & 63;
#pragma unroll
        for (int pp = 0; pp < 2; ++pp) { const int pos = pp ? pc : pr; float x1[8], x2[8]; unpack8(__builtin_bit_cast(u32x4, qr[qb0 + 2 * pp]), x1); unpack8(__builtin_bit_cast(u32x4, qr[qb0 + 1 + 2 * pp]), x2);
#pragma unroll
            for (int e = 0; e < 8; ++e) { const f32x2 cs = *(const f32x2*)(rtab + (size_t)(pos * 32 + 2 * (hi * 8 + e)) * 2); const float a = x1[e] * cs.x - x2[e] * cs.y, b = x1[e] * cs.y + x2[e] * cs.x; x1[e] = a; x2[e] = b; }
            qr[qb0 + 2 * pp] = __builtin_bit_cast(bf16x8, pack8(x1)); qr[qb0 + 1 + 2 * pp] = __builtin_bit_cast(bf16x8, pack8(x2)); }
    } }
    const bf16_t* kp[NKC]; int kstep[NKC], kd[NKC];
#pragma unroll
    for (int i = 0; i < NKC; ++i) { const int idx = tid + 512 * i, key = idx / (2 * NDQ), ch = idx - key * (2 * NDQ); const bool main = ch < 2 * NDA;
        kp[i] = main ? K + (size_t)key * ldk + ch * 8 : K2 + (size_t)key * ldk2 + (ch - 2 * NDA) * 8; kstep[i] = 64 * (main ? ldk : ldk2); kd[i] = key * ROWK + ch * 16; }
    const bf16_t* vp = V + (size_t)lane * ldv + wave * 16; const int vd = KB + (wave * 16) * 136 + lane * 2; const size_t vstep = (size_t)64 * ldv;
    u32x4 ks[NKC], vs[2];
#define AW_LOAD() do { _Pragma("unroll") for (int i = 0; i < NKC; ++i) { ks[i] = *(const u32x4*)kp[i]; kp[i] += kstep[i]; } vs[0] = *(const u32x4*)vp; vs[1] = *(const u32x4*)(vp + 8); vp += vstep; } while (0)
#define AW_WRITE(b) do { _Pragma("unroll") for (int i = 0; i < NKC; ++i) *(LAS u32x4*)(lds + (b) * BUF + kd[i]) = ks[i]; \
        _Pragma("unroll") for (int i = 0; i < 2; ++i) _Pragma("unroll") for (int e = 0; e < 8; ++e) { const unsigned ww = vs[i][e >> 1]; \
            *(LAS unsigned short*)(lds + (b) * BUF + vd + (8 * i + e) * 136) = (unsigned short)((e & 1) ? (ww >> 16) : (ww & 0xffffu)); } } while (0)
#pragma unroll
    for (int d0 = 0; d0 < 4; ++d0)
#pragma unroll
        for (int r = 0; r < 16; ++r) o[d0][r] = 0.f;
    float m = -1e30f, l = 0.f;
    const int NT = nkeys >> 6;
    AW_LOAD(); AW_WRITE(0); __syncthreads();
    const int koff = r32 * ROWK + hi * 16, voff = KB + r32 * 136 + hi * 8;
    for (int t = 0; t < NT; ++t) {
        const int b = t & 1;
        if (t + 1 < NT) AW_LOAD();
        const LAS unsigned char* kb = lds + b * BUF + koff; const LAS unsigned char* vb = lds + b * BUF + voff;
        f32x16 p0, p1;
#pragma unroll
        for (int r = 0; r < 16; ++r) { p0[r] = 0.f; p1[r] = 0.f; }
#pragma unroll
        for (int d0 = 0; d0 < NDQ; ++d0) { const bf16x8 a0 = *(const LAS bf16x8*)(kb + d0 * 32), a1 = *(const LAS bf16x8*)(kb + 32 * ROWK + d0 * 32);
            p0 = MFMA32(a0, qr[d0], p0); p1 = MFMA32(a1, qr[d0], p1); }
        float tm = fmaxf(p0[0], p1[0]);
#pragma unroll
        for (int r = 1; r < 16; ++r) tm = fmaxf(tm, fmaxf(p0[r], p1[r]));
        tm = xor32_max(tm);
        const float mn = fmaxf(m, tm), alpha = __builtin_amdgcn_exp2f((m - mn) * C), mC = mn * C; m = mn;
        float ps = 0.f;
#pragma unroll
        for (int r = 0; r < 16; ++r) { p0[r] = __builtin_amdgcn_exp2f(p0[r] * C - mC); p1[r] = __builtin_amdgcn_exp2f(p1[r] * C - mC); ps += p0[r] + p1[r]; }
        l = l * alpha + ps;
        if (!__all(alpha == 1.0f)) {
#pragma unroll
            for (int d0 = 0; d0 < 4; ++d0)
#pragma unroll
                for (int r = 0; r < 16; ++r) o[d0][r] *= alpha;
        }
        const bf16x8 pb00 = pack_step(p0, 0), pb01 = pack_step(p0, 1), pb10 = pack_step(p1, 0), pb11 = pack_step(p1, 1);
#pragma unroll
        for (int d0 = 0; d0 < 4; ++d0) { const LAS unsigned char* v0 = vb + d0 * 32 * 136;
            o[d0] = MFMA32(cat4(*(const LAS s16x4*)(v0), *(const LAS s16x4*)(v0 + 16)), pb00, o[d0]);
            o[d0] = MFMA32(cat4(*(const LAS s16x4*)(v0 + 32), *(const LAS s16x4*)(v0 + 48)), pb01, o[d0]);
            o[d0] = MFMA32(cat4(*(const LAS s16x4*)(v0 + 64), *(const LAS s16x4*)(v0 + 80)), pb10, o[d0]);
            o[d0] = MFMA32(cat4(*(const LAS s16x4*)(v0 + 96), *(const LAS s16x4*)(v0 + 112)), pb11, o[d0]); }
        if (t + 1 < NT) AW_WRITE(b ^ 1);
        __syncthreads();
    }
#undef AW_LOAD
#undef AW_WRITE
    l_out = xor32_sum(l);
}
DI void store_ot(const f32x16 (&o)[4], float inv, bf16_t* dst, int ld, int lane) {
    const int r32 = lane & 31, hi = lane >> 5; bf16_t* p = dst + (size_t)r32 * ld + 4 * hi;
#pragma unroll
    for (int d0 = 0; d0 < 4; ++d0)
#pragma unroll
        for (int g = 0; g < 4; ++g) { u32x2 w; w.x = pk2(o[d0][4 * g] * inv, o[d0][4 * g + 1] * inv); w.y = pk2(o[d0][4 * g + 2] * inv, o[d0][4 * g + 3] * inv); *(u32x2*)(p + d0 * 32 + 8 * g) = w; }
}
constexpr float C_DA = 0.125f * 1.4426950408889634f, C_GQ = 0.08838834764831845f * 1.4426950408889634f, C_MLA = 0.07216878364870323f * 1.4426950408889634f;
DI void da_unit(int idx, int j, const bf16_t* raw, const bf16_t* KAd, const bf16_t* VAd, const float* dalam, const float* daln, float lam_init, bf16_t* mix, const float* tab, LAS unsigned char* lds, int tid) {
    const int lane = tid & 63, wave = __builtin_amdgcn_readfirstlane(tid >> 6), hi = lane >> 5;
    const bool dec = idx < 64; int b, hh, qb; if (dec) { b = idx >> 5; hh = (idx >> 2) & 7; qb = idx & 3; } else { const int i2 = idx - 64; b = i2 >> 3; hh = i2 & 7; qb = 0; }
    const int row0 = dec ? NCTX + b * 1024 + qb * 256 : b * 256, nkeys = dec ? 1280 : 256;
    const bf16_t* Q = raw + (size_t)row0 * EVEN_IN + hh * 128;
    const bf16_t* K = dec ? KAd + (size_t)(b * 1280) * 1024 + hh * 128 : raw + (size_t)(b * 256) * EVEN_IN + 1024 + hh * 128; const int ldk = dec ? 1024 : EVEN_IN;
    const bf16_t* Vt = dec ? VAd + (size_t)(b * 1280) * 1024 + hh * 128 : raw + (size_t)(b * 256) * EVEN_IN + 2048 + hh * 128; const int ldvt = dec ? 1024 : EVEN_IN;
    f32x16 o[4]; float l;
    LAS u32x4* park = (LAS u32x4*)(lds + 53248 + wave * 8192) + lane;
#pragma unroll 1
    for (int c = 0; c < 2; ++c) {
        attn_wg<4, 4>(Q + c * 64, EVEN_IN, K + c * 64, ldk, K + c * 64, ldk, nkeys, Vt, ldvt, C_DA, o, l, lds, tid, dec ? tab : (const float*)nullptr, qb * 256);
        if (c == 0) { const float i0 = 1.0f / l;
#pragma unroll
            for (int d0 = 0; d0 < 4; ++d0)
#pragma unroll
                for (int hf = 0; hf < 2; ++hf) { u32x4 w; w.x = pk2(o[d0][8 * hf] * i0, o[d0][8 * hf + 1] * i0); w.y = pk2(o[d0][8 * hf + 2] * i0, o[d0][8 * hf + 3] * i0);
                    w.z = pk2(o[d0][8 * hf + 4] * i0, o[d0][8 * hf + 5] * i0); w.w = pk2(o[d0][8 * hf + 6] * i0, o[d0][8 * hf + 7] * i0); park[(d0 * 2 + hf) * 64] = w; } }
    }
    const float* lm = dalam + j * 256;
    const float s1 = wave_sum(lm[lane] * lm[64 + lane]), s2 = wave_sum(lm[128 + lane] * lm[192 + lane]);
    const float lam = fexp(s1) - fexp(s2) + lam_init;
    const float i1 = lam / l; float ss = 0.f;
    f32x16 o0[4];
#pragma unroll
    for (int d0 = 0; d0 < 4; ++d0)
#pragma unroll
        for (int hf = 0; hf < 2; ++hf) { const u32x4 w = park[(d0 * 2 + hf) * 64]; float f[8]; unpack8(w, f);
#pragma unroll
            for (int e = 0; e < 8; ++e) { const float v = f[e] - o[d0][8 * hf + e] * i1; o0[d0][8 * hf + e] = v; ss += v * v; } }
    ss = xor32_sum(ss);
    const float rstd = frsq(ss * (1.0f / 128.0f) + EPS) * (1.0f - lam_init);
    const float* gg = daln + j * 128 + 4 * hi;
#pragma unroll
    for (int d0 = 0; d0 < 4; ++d0)
#pragma unroll
        for (int g = 0; g < 4; ++g) { const f32x4 g4 = *(const f32x4*)(gg + d0 * 32 + 8 * g);
            o0[d0][4 * g] *= g4.x; o0[d0][4 * g + 1] *= g4.y; o0[d0][4 * g + 2] *= g4.z; o0[d0][4 * g + 3] *= g4.w; }
    store_ot(o0, rstd, mix + (size_t)(row0 + wave * 32) * DM + hh * 128, DM, lane);
}
DI void gqa_unit(int idx, const bf16_t* raw, const bf16_t* KBd, const bf16_t* VBd, bf16_t* mix, const float* qgain, const float* tab, LAS unsigned char* lds, int tid) {
    const int lane = tid & 63, wave = __builtin_amdgcn_readfirstlane(tid >> 6);
    const bool dec = idx < 64; int b, hh, qb; if (dec) { b = idx >> 5; hh = (idx >> 2) & 7; qb = idx & 3; } else { const int i2 = idx - 64; b = i2 >> 3; hh = i2 & 7; qb = 0; }
    const int row0 = dec ? NCTX + b * 1024 + qb * 256 : b * 256, nkeys = dec ? 1280 : 256, g = hh >> 2;
    const bf16_t* Q = raw + (size_t)row0 * EVEN_IN + 3072 + hh * 128;
    const bf16_t* K = dec ? KBd + (size_t)(b * 1280) * 256 + g * 128 : raw + (size_t)(b * 256) * EVEN_IN + 4096 + g * 128; const int ldk = dec ? 256 : EVEN_IN;
    const bf16_t* Vt = dec ? VBd + (size_t)(b * 1280) * 256 + g * 128 : raw + (size_t)(b * 256) * EVEN_IN + 4352 + g * 128; const int ldvt = dec ? 256 : EVEN_IN;
    f32x16 o[4]; float l;
    attn_wg<8, 8>(Q, EVEN_IN, K, ldk, K, ldk, nkeys, Vt, ldvt, C_GQ, o, l, lds, tid, dec ? tab : (const float*)nullptr, qb * 256, qgain);
    store_ot(o, 1.0f / l, mix + (size_t)(row0 + wave * 32) * DM + 1024 + hh * 128, DM, lane);
}
DI int mkv_row(int row) { return row < NCTX ? row : NCTX + ((row - NCTX) >> 10) * 1280 + 256 + ((row - NCTX) & 1023); }
DI void opost_row(const bf16_t* raw, const bf16_t* P2, int row, int j, float* out, const float* gate_b, const float* qng, const float* kvng, float* G, bf16_t* QD, bf16_t* CKV, bf16_t* KPE, const float* tab, int lane) {
    int b, t, T, v; row_info(row, b, t, T, v); const bool dec = row >= NCTX; const int pr = t >> 6, pc = t & 63, mrow = mkv_row(row);
    const bf16_t* rp = raw + (size_t)row * ODD_INP;
    const bf16_t* pp = P2 + (size_t)row * 128; unsigned short gq[4]; u32x4 pe4[4];
#pragma unroll
    for (int k = 0; k < 4; ++k) { gq[k] = pp[(size_t)k * MTOK * 128 + 64 + (lane & 31)]; pe4[k] = *(const u32x4*)(pp + (size_t)k * MTOK * 128 + (lane & 7) * 8); }
    const u32x4 wq = *(const u32x4*)(rp + 4096 + lane * 8), wkv = *(const u32x4*)(rp + 4608 + (lane & 31) * 8);
    const float graw = (bf2f(gq[0]) + bf2f(gq[1])) + (bf2f(gq[2]) + bf2f(gq[3]));
    if (lane < 32) { float val = graw + gate_b[j * 32 + lane]; const int k = lane >> 3, hh = lane & 7; if (k & 1) val = logsigmoidf_(val); G[((size_t)k * MTOK + row) * 8 + hh] = val; }
    {
        const u32x4 w = wq; float f[8]; unpack8(w, f); float ss = 0.f;
#pragma unroll
        for (int e = 0; e < 8; ++e) ss += f[e] * f[e];
        ss = wave_sum(ss); const float rstd = frsq(ss * (1.0f / 512.0f) + EPS);
#pragma unroll
        for (int e = 0; e < 8; ++e) f[e] = f[e] * rstd * qng[j * 512 + lane * 8 + e];
        *(u32x4*)(QD + (size_t)row * 512 + lane * 8) = pack8(f);
    }
    {
        float f[8]; float ss = 0.f;
        if (lane < 32) { const u32x4 w = wkv; unpack8(w, f);
#pragma unroll
            for (int e = 0; e < 8; ++e) ss += f[e] * f[e]; }
        else {
#pragma unroll
            for (int e = 0; e < 8; ++e) f[e] = 0.f; }
        ss = wave_sum(ss); const float rstd = frsq(ss * (1.0f / 256.0f) + EPS);
        if (lane < 32) {
#pragma unroll
            for (int e = 0; e < 8; ++e) f[e] = f[e] * rstd * kvng[j * 256 + lane * 8 + e];
            *(u32x4*)(CKV + (size_t)mrow * 256 + lane * 8) = pack8(f);
            if (!dec) { float* o = out + O_CKV + ((size_t)(b * 2 + j) * 256 + t) * 256 + lane * 8; *(f32x4*)o = (f32x4){f[0], f[1], f[2], f[3]}; *(f32x4*)(o + 4) = (f32x4){f[4], f[5], f[6], f[7]}; }
        }
    }
    {
        float f[8];
        if (lane < 8) { float a0[8], a1[8], a2[8], a3[8]; unpack8(pe4[0], a0); unpack8(pe4[1], a1); unpack8(pe4[2], a2); unpack8(pe4[3], a3);
#pragma unroll
            for (int e = 0; e < 8; ++e) f[e] = (a0[e] + a1[e]) + (a2[e] + a3[e]); }
        else {
#pragma unroll
            for (int e = 0; e < 8; ++e) f[e] = 0.f; }
        if (!dec) { if (lane < 8) { float* o = out + O_KPE + ((size_t)(b * 2 + j) * 256 + t) * 64 + lane * 8; *(f32x4*)o = (f32x4){f[0], f[1], f[2], f[3]}; *(f32x4*)(o + 4) = (f32x4){f[4], f[5], f[6], f[7]}; } }
        else rope_chunk<16>(f, lane & 7, tab, pr, pc);
        if (lane < 8) *(u32x4*)(KPE + (size_t)mrow * 64 + lane * 8) = pack8(f);
    }
}
DI void opost_conv(const bf16_t* raw, int item, int j, const float* cw, const float* cb, bf16_t* QM, bf16_t* KM, int lane) {
    const int rb = item >> 2, cg = item & 3, row0 = rb * 8, c0 = (cg * 64 + lane) * 8;
    int b, t0, T, v; row_info(row0, b, t0, T, v);
    const bf16_t* r0 = raw + (size_t)row0 * ODD_INP + c0; const u32x4 z = {0u, 0u, 0u, 0u};
    u32x4 xq[10];
#pragma unroll
    for (int i = 0; i < 10; ++i) { const int t = t0 + i - 1; const bool ok = (t >= 0) && (t < T); xq[i] = ok ? *(const u32x4*)(r0 + (long)(i - 1) * ODD_INP) : z; }
    const float* w0 = cw + (size_t)j * 3 * 2048 + c0; const float* bb = cb + (size_t)j * 2048 + c0;
    f32x4 wk[3][2], bk[2];
#pragma unroll
    for (int e = 0; e < 2; ++e) { bk[e] = *(const f32x4*)(bb + 4 * e);
#pragma unroll
        for (int k = 0; k < 3; ++k) wk[k][e] = *(const f32x4*)(w0 + (size_t)k * 2048 + 4 * e); }
    const bool isq = cg < 2; const float osc = isq ? 0.08838834764831845f : 1.0f;
    u32x4 ov[8];
#pragma unroll
    for (int i = 0; i < 8; ++i) { float a[8], bq[8], c[8], y[8]; unpack8(xq[i], a); unpack8(xq[i + 1], bq); unpack8(xq[i + 2], c);
#pragma unroll
        for (int e = 0; e < 2; ++e)
#pragma unroll
            for (int q = 0; q < 4; ++q) { const int x = 4 * e + q; const float s = bk[e][q] + wk[0][e][q] * a[x] + wk[1][e][q] * bq[x] + wk[2][e][q] * c[x]; y[x] = siluf_(s) * osc; }
        ov[i] = pack8(y); }
    bf16_t* dst = (isq ? QM : KM) + (size_t)row0 * 1024 + (isq ? c0 : c0 - 1024);
#pragma unroll
    for (int i = 0; i < 8; ++i) *(u32x4*)(dst + (size_t)i * 1024) = ov[i];
}
DI void opost_cache(int item, int j, const float* cckv, const float* ckpe, bf16_t* CKV, bf16_t* KPE, int lane) {
    const int b = item >> 8, s = item & 255; const size_t mrow = NCTX + b * 1280 + s;
    if (lane < 32) { const float* src = cckv + ((size_t)(b * 2 + j) * 256 + s) * 256 + lane * 8; const f32x4 a = *(const f32x4*)src, bb = *(const f32x4*)(src + 4);
        u32x4 w; w.x = pk2(a.x, a.y); w.y = pk2(a.z, a.w); w.z = pk2(bb.x, bb.y); w.w = pk2(bb.z, bb.w); *(u32x4*)(CKV + mrow * 256 + lane * 8) = w; }
    else if (lane < 40) { const int l8 = lane - 32; const float* src = ckpe + ((size_t)(b * 2 + j) * 256 + s) * 64 + l8 * 8; const f32x4 a = *(const f32x4*)src, bb = *(const f32x4*)(src + 4);
        u32x4 w; w.x = pk2(a.x, a.y); w.y = pk2(a.z, a.w); w.z = pk2(bb.x, bb.y); w.w = pk2(bb.z, bb.w); *(u32x4*)(KPE + mrow * 64 + l8 * 8) = w; }
}
DI void lds_barrier() { asm volatile("s_waitcnt lgkmcnt(0)" ::: "memory"); __builtin_amdgcn_s_barrier(); asm volatile("" ::: "memory"); }
constexpr int ML_Q = 0, ML_K = 16896, ML_KT = 33792, ML_VT = 52224, ML_DIR = 69632;
DI void mlstm_wg(int unit, int dirsel, int j, const bf16_t* QM, const bf16_t* KM, const bf16_t* RAWV, const float* G, const float* stC, const float* stN, const float* stM,
                 bf16_t* HF, float* out, const float* mlng, bf16_t* mix, LAS unsigned char* lds, LAS float* scbase, int tid) {
    const int lane = tid & 63, wave = __builtin_amdgcn_readfirstlane(tid >> 6), r32 = lane & 31, hi = lane >> 5, vb = wave & 3, tl = tid & 255;
    const int dir = (dirsel < 0) ? (wave >> 2) : dirsel; const bool active = (dirsel < 0) || (wave < 4);
    const bool isdec = unit < 16; const int u2 = isdec ? unit : unit - 16, b = u2 >> 3, h = u2 & 7;
    const int T = isdec ? 1024 : 256, nc = T >> 6, row0 = isdec ? NCTX + b * 1024 : b * 256;
    LAS unsigned char* Ld = lds + ((dirsel < 0) ? dir : 0) * ML_DIR;
    LAS float* sc = scbase + wave * 384; LAS float* sU = sc; LAS float* sM = sc + 64; LAS float* sB = sc + 128; LAS float* sW = sc + 192; LAS float* sN = sc + 256;
    f32x16 C[4]; float m_prev = 0.f;
    const size_t sidx = (((size_t)(b * 2 + j) * 2 + dir) * 8 + h);
#pragma unroll
    for (int dkb = 0; dkb < 4; ++dkb)
#pragma unroll
        for (int r = 0; r < 16; ++r) C[dkb][r] = 0.f;
    if (!active) { } else if (isdec) {
        const float* cp = stC + sidx * 16384 + vb * 32 + r32;
#pragma unroll
        for (int dkb = 0; dkb < 4; ++dkb)
#pragma unroll
            for (int r = 0; r < 16; ++r) C[dkb][r] = cp[(size_t)(dkb * 32 + crow(r, hi)) * 128];
        sN[lane] = stN[sidx * 128 + lane]; sN[64 + lane] = stN[sidx * 128 + 64 + lane]; m_prev = stM[sidx];
    } else {
#pragma unroll
        for (int dkb = 0; dkb < 4; ++dkb)
#pragma unroll
            for (int r = 0; r < 16; ++r) C[dkb][r] = 0.f;
        sN[lane] = 0.f; sN[64 + lane] = 0.f; m_prev = 0.f;
    }
    const float* GIp = G + ((size_t)(2 * dir) * MTOK) * 8 + h; const float* GFp = G + ((size_t)(2 * dir + 1) * MTOK) * 8 + h;
    const int mj = dir ? 63 - lane : lane;
    (void)tl;
    const bool lmode = dirsel >= 0;
    auto stage_all = [&](LAS unsigned char* Lb, int tk0) {
        u32x4 a[4], c[4], vv[4];
        const size_t roff = (size_t)(tk0 + lane) * 1024 + h * 128 + vb * 16, voff = (size_t)(tk0 + lane) * ODD_INP + 2048 + h * 128 + vb * 16;
#pragma unroll
        for (int i = 0; i < 4; ++i) { a[i] = *(const u32x4*)(QM + roff + 8 * (i & 1) + 64 * (i >> 1)); c[i] = *(const u32x4*)(KM + roff + 8 * (i & 1) + 64 * (i >> 1)); vv[i] = *(const u32x4*)(RAWV + voff + 8 * (i & 1) + 64 * (i >> 1)); }
#pragma unroll
        for (int i = 0; i < 4; ++i) { const int c16 = 2 * vb + (i & 1) + 8 * (i >> 1);
            LAS u32x2* dq = (LAS u32x2*)(Lb + ML_Q + lane * 264 + c16 * 16); dq[0] = (u32x2){a[i].x, a[i].y}; dq[1] = (u32x2){a[i].z, a[i].w};
            LAS u32x2* dk = (LAS u32x2*)(Lb + ML_K + lane * 264 + c16 * 16); dk[0] = (u32x2){c[i].x, c[i].y}; dk[1] = (u32x2){c[i].z, c[i].w};
#pragma unroll
            for (int e = 0; e < 8; ++e) { const unsigned ww = c[i][e >> 1]; *(LAS unsigned short*)(Lb + ML_KT + (c16 * 8 + e) * 144 + lane * 2) = (unsigned short)((e & 1) ? (ww >> 16) : (ww & 0xffffu)); }
#pragma unroll
            for (int e = 0; e < 8; ++e) { const unsigned ww = vv[i][e >> 1]; *(LAS unsigned short*)(Lb + ML_VT + (c16 * 8 + e) * 136 + lane * 2) = (unsigned short)((e & 1) ? (ww >> 16) : (ww & 0xffffu)); } }
    };
    float li_n = 0.f, lf_n = 0.f;
    if (lmode) { const int tk0 = row0 + (dir ? nc - 1 : 0) * 64;
        if (wave >= 4) stage_all(lds, tk0); else { li_n = GIp[(size_t)(tk0 + mj) * 8]; lf_n = GFp[(size_t)(tk0 + mj) * 8]; } }
#pragma unroll 1
    for (int ci = 0; ci < nc; ++ci) {
        const int chunk = dir ? nc - 1 - ci : ci, tok0 = row0 + chunk * 64;
        lds_barrier();
        LAS unsigned char* Lc = Ld;
        if (lmode) {
            const int tk1 = row0 + (dir ? nc - 2 - ci : ci + 1) * 64;
            if (wave >= 4) { if (ci + 1 < nc) stage_all(lds + ((ci + 1) & 1) * ML_DIR, tk1); continue; }
            const float li = li_n, lf = lf_n;
            if (ci + 1 < nc) { li_n = GIp[(size_t)(tk1 + mj) * 8]; lf_n = GFp[(size_t)(tk1 + mj) * 8]; }
            {
                const float bc = wave_scan_sum(lf);
                const float u = li - bc; const float pmx = wave_scan_max(u);
                const float Mv = fmaxf(m_prev, pmx);
                const float Mend_ = __uint_as_float((unsigned)__builtin_amdgcn_readlane((int)__float_as_uint(Mv), 63));
                sU[mj] = u; sM[mj] = Mv; sB[mj] = bc; sW[mj] = fexp(u - Mend_);
            }
            Lc = lds + (ci & 1) * ML_DIR;
        } else {
        {
            u32x4 a[4], c[4], vv[4];
            const size_t voff = (size_t)(tok0 + lane) * ODD_INP + 2048 + h * 128 + vb * 16;
            const size_t roff = (size_t)(tok0 + lane) * 1024 + h * 128 + vb * 16;
#pragma unroll
            for (int i = 0; i < 4; ++i) { a[i] = *(const u32x4*)(QM + roff + 8 * (i & 1) + 64 * (i >> 1)); c[i] = *(const u32x4*)(KM + roff + 8 * (i & 1) + 64 * (i >> 1)); vv[i] = *(const u32x4*)(RAWV + voff + 8 * (i & 1) + 64 * (i >> 1)); }
            const float li = GIp[(size_t)(tok0 + mj) * 8], lf = GFp[(size_t)(tok0 + mj) * 8];
#pragma unroll
            for (int i = 0; i < 4; ++i) { const int c16 = 2 * vb + (i & 1) + 8 * (i >> 1);
                LAS u32x2* dq = (LAS u32x2*)(Ld + ML_Q + lane * 264 + c16 * 16); dq[0] = (u32x2){a[i].x, a[i].y}; dq[1] = (u32x2){a[i].z, a[i].w};
                LAS u32x2* dk = (LAS u32x2*)(Ld + ML_K + lane * 264 + c16 * 16); dk[0] = (u32x2){c[i].x, c[i].y}; dk[1] = (u32x2){c[i].z, c[i].w};
#pragma unroll
                for (int e = 0; e < 8; ++e) { const unsigned ww = c[i][e >> 1]; *(LAS unsigned short*)(Ld + ML_KT + (c16 * 8 + e) * 144 + lane * 2) = (unsigned short)((e & 1) ? (ww >> 16) : (ww & 0xffffu)); } }
            __builtin_amdgcn_sched_barrier(0);
            {
                const float bc = wave_scan_sum(lf);
                const float u = li - bc; const float pmx = wave_scan_max(u);
                const float Mv = fmaxf(m_prev, pmx);
                const float Mend_ = __uint_as_float((unsigned)__builtin_amdgcn_readlane((int)__float_as_uint(Mv), 63));
                sU[mj] = u; sM[mj] = Mv; sB[mj] = bc; sW[mj] = fexp(u - Mend_);
            }
#pragma unroll
            for (int i = 0; i < 4; ++i) { const int c16 = 2 * vb + (i & 1) + 8 * (i >> 1);
#pragma unroll
                for (int e = 0; e < 8; ++e) { const unsigned ww = vv[i][e >> 1]; *(LAS unsigned short*)(Ld + ML_VT + (c16 * 8 + e) * 136 + lane * 2) = (unsigned short)((e & 1) ? (ww >> 16) : (ww & 0xffffu)); } }
            __builtin_amdgcn_sched_barrier(0);
        }
        lds_barrier();
        }
        const float Mend = sM[dir ? 0 : 63], bend = sB[dir ? 0 : 63];
        const float decay = fexp(m_prev - Mend);
        const LAS unsigned char* vrow = Lc + ML_VT + (vb * 32 + r32) * 136;
#pragma unroll 1
        for (int tb = 0; tb < 2; ++tb) {
            const int t_m = tb * 32 + r32;
            const LAS unsigned char* qp = Lc + ML_Q + t_m * 264 + hi * 8;
            const LAS unsigned char* kp0 = Lc + ML_K + r32 * 264 + hi * 8; const LAS unsigned char* kp1 = kp0 + 32 * 264;
            const float Mt = sM[t_m], Bt = sB[t_m], a_t = fexp(m_prev - Mt); const int tq = t_m - 4 * hi;
            f32x16 st0, st1, N; float qn = 0.f;
#pragma unroll
            for (int r = 0; r < 16; ++r) { st0[r] = 0.f; st1[r] = 0.f; N[r] = 0.f; }
#pragma unroll 2
            for (int d0 = 0; d0 < 8; ++d0) {
                const bf16x8 qf = cat4(*(const LAS s16x4*)(qp + d0 * 32), *(const LAS s16x4*)(qp + d0 * 32 + 16));
                const bf16x8 k0 = cat4(*(const LAS s16x4*)(kp0 + d0 * 32), *(const LAS s16x4*)(kp0 + d0 * 32 + 16));
                const bf16x8 k1 = cat4(*(const LAS s16x4*)(kp1 + d0 * 32), *(const LAS s16x4*)(kp1 + d0 * 32 + 16));
                st0 = MFMA32(k0, qf, st0); st1 = MFMA32(k1, qf, st1);
                const f32x4 n0 = *(const LAS f32x4*)(sN + 16 * d0 + 4 * hi), n1 = *(const LAS f32x4*)(sN + 16 * d0 + 8 + 4 * hi);
                qn += bf2f((unsigned short)qf[0]) * n0.x + bf2f((unsigned short)qf[1]) * n0.y + bf2f((unsigned short)qf[2]) * n0.z + bf2f((unsigned short)qf[3]) * n0.w
                    + bf2f((unsigned short)qf[4]) * n1.x + bf2f((unsigned short)qf[5]) * n1.y + bf2f((unsigned short)qf[6]) * n1.z + bf2f((unsigned short)qf[7]) * n1.w;
            }
            __builtin_amdgcn_sched_barrier(0);
#pragma unroll
            for (int d0 = 0; d0 < 8; ++d0) {
                const bf16x8 qf = cat4(*(const LAS s16x4*)(qp + d0 * 32), *(const LAS s16x4*)(qp + d0 * 32 + 16));
                N = MFMA32(pack_step(C[d0 >> 1], d0 & 1), qf, N);
            }
            __builtin_amdgcn_sched_barrier(0);
            float rs = 0.f;
#pragma unroll
            for (int g = 0; g < 4; ++g) {
                const f32x4 u0 = *(const LAS f32x4*)(sU + 8 * g + 4 * hi), u1 = *(const LAS f32x4*)(sU + 32 + 8 * g + 4 * hi);
#pragma unroll
                for (int i = 0; i < 4; ++i) { const int r = 4 * g + i, c0 = 8 * g + i, c1 = 32 + c0;
                    const bool ok0 = dir ? (c0 >= tq) : (c0 <= tq), ok1 = dir ? (c1 >= tq) : (c1 <= tq);
                    const float w0 = fexp(fminf(u0[i] - Mt, 0.f)), w1 = fexp(fminf(u1[i] - Mt, 0.f));
                    st0[r] = ok0 ? st0[r] * w0 : 0.f; st1[r] = ok1 ? st1[r] * w1 : 0.f; rs += st0[r] + st1[r]; }
            }
#pragma unroll
            for (int r = 0; r < 16; ++r) N[r] *= a_t;
            const LAS unsigned char* vp = vrow + hi * 8;
            N = MFMA32(cat4(*(const LAS s16x4*)(vp), *(const LAS s16x4*)(vp + 16)), pack_step(st0, 0), N);
            N = MFMA32(cat4(*(const LAS s16x4*)(vp + 32), *(const LAS s16x4*)(vp + 48)), pack_step(st0, 1), N);
            N = MFMA32(cat4(*(const LAS s16x4*)(vp + 64), *(const LAS s16x4*)(vp + 80)), pack_step(st1, 0), N);
            N = MFMA32(cat4(*(const LAS s16x4*)(vp + 96), *(const LAS s16x4*)(vp + 112)), pack_step(st1, 1), N);
            qn = xor32_sum(qn); rs = xor32_sum(rs);
            const float den = rs + a_t * qn, dn = fmaxf(fabsf(den), fexp(-(Bt + Mt))), inv = 1.0f / dn;
            bf16_t* hp = HF + ((size_t)dir * MTOK + tok0 + t_m) * 1024 + h * 128 + vb * 32 + 8 * hi;
#pragma unroll
            for (int g = 0; g < 4; g += 2) {
                const unsigned a0 = pk2(N[4 * g] * inv, N[4 * g + 1] * inv), a1 = pk2(N[4 * g + 2] * inv, N[4 * g + 3] * inv), b0 = pk2(N[4 * g + 4] * inv, N[4 * g + 5] * inv), b1 = pk2(N[4 * g + 6] * inv, N[4 * g + 7] * inv);
                const auto r0 = __builtin_amdgcn_permlane32_swap(a0, b0, false, false), r1 = __builtin_amdgcn_permlane32_swap(a1, b1, false, false);
                *(u32x4*)(hp + 8 * g) = (u32x4){r0[0], r1[0], r0[1], r1[1]}; }
        }
        bf16x8 vw[4];
#pragma unroll
        for (int ks = 0; ks < 4; ++ks) { const LAS unsigned char* v0 = vrow + (16 * ks + 8 * hi) * 2; const u32x2 wa = *(const LAS u32x2*)v0, wb = *(const LAS u32x2*)(v0 + 8);
            float f[8]; f[0] = bf_lo(wa.x); f[1] = bf_hi(wa.x); f[2] = bf_lo(wa.y); f[3] = bf_hi(wa.y); f[4] = bf_lo(wb.x); f[5] = bf_hi(wb.x); f[6] = bf_lo(wb.y); f[7] = bf_hi(wb.y);
            const f32x4 w0 = *(const LAS f32x4*)(sW + 16 * ks + 8 * hi), w1 = *(const LAS f32x4*)(sW + 16 * ks + 8 * hi + 4);
            f[0] *= w0.x; f[1] *= w0.y; f[2] *= w0.z; f[3] *= w0.w; f[4] *= w1.x; f[5] *= w1.y; f[6] *= w1.z; f[7] *= w1.w;
            vw[ks] = __builtin_bit_cast(bf16x8, pack8(f)); }
#pragma unroll
        for (int dkb = 0; dkb < 4; ++dkb) {
#pragma unroll
            for (int r = 0; r < 16; ++r) C[dkb][r] *= decay;
            float na = 0.f; const LAS unsigned char* ktp = Lc + ML_KT + (dkb * 32 + r32) * 144 + hi * 16;
#pragma unroll
            for (int ks = 0; ks < 4; ++ks) { const u32x4 w = *(const LAS u32x4*)(ktp + 32 * ks); C[dkb] = MFMA32(__builtin_bit_cast(bf16x8, w), vw[ks], C[dkb]); float f[8]; unpack8(w, f);
                const f32x4 w0 = *(const LAS f32x4*)(sW + 16 * ks + 8 * hi), w1 = *(const LAS f32x4*)(sW + 16 * ks + 8 * hi + 4);
                na += f[0] * w0.x + f[1] * w0.y + f[2] * w0.z + f[3] * w0.w + f[4] * w1.x + f[5] * w1.y + f[6] * w1.z + f[7] * w1.w; }
            na = xor32_sum(na);
            const float nn = decay * sN[dkb * 32 + r32] + na;
            if (hi == 0) sN[dkb * 32 + r32] = nn;
            __builtin_amdgcn_sched_barrier(0);
        }
        m_prev = bend + Mend;
    }
    if (active && !isdec) {
        float* cp = out + O_MLC + sidx * 16384 + vb * 32 + r32;
#pragma unroll
        for (int dkb = 0; dkb < 4; ++dkb)
#pragma unroll
            for (int r = 0; r < 16; ++r) cp[(size_t)(dkb * 32 + crow(r, hi)) * 128] = C[dkb][r];
        if (vb == 0) { out[O_MLN + sidx * 128 + lane] = sN[lane]; out[O_MLN + sidx * 128 + 64 + lane] = sN[64 + lane]; if (lane == 0) out[O_MLM + sidx] = m_prev; }
    }
    __syncthreads();
    if (!isdec) {
#pragma unroll 1
        for (int i0 = 0; i0 < 8; i0 += 4) {
            u32x4 w0[4], w1[4], ow[4];
#pragma unroll
            for (int i = 0; i < 4; ++i) { const size_t row = row0 + (tid >> 4) + 32 * (i0 + i); const int c0 = h * 128 + (tid & 15) * 8;
                w0[i] = *(const u32x4*)(HF + row * 1024 + c0); w1[i] = *(const u32x4*)(HF + ((size_t)MTOK + row) * 1024 + c0); ow[i] = *(const u32x4*)(RAWV + row * ODD_INP + 3072 + c0); }
#pragma unroll
            for (int i = 0; i < 4; ++i) { const size_t row = row0 + (tid >> 4) + 32 * (i0 + i); const int cl = (tid & 15) * 8;
                float f[8], f1[8], om[8]; unpack8(w0[i], f); unpack8(w1[i], f1); unpack8(ow[i], om); float ss = 0.f;
#pragma unroll
                for (int e = 0; e < 8; ++e) { f[e] += f1[e]; ss += f[e] * f[e]; }
                ss = grp16_sum(ss); const float rstd = frsq(ss * (1.0f / 128.0f) + EPS);
#pragma unroll
                for (int e = 0; e < 8; ++e) f[e] = f[e] * rstd * mlng[cl + e] * sigmoidf_(om[e]);
                *(u32x4*)(mix + row * DM + h * 128 + cl) = pack8(f); }
        }
    }
}
DI void mla_unit(int idx, const bf16_t* CQ, const bf16_t* KV, const bf16_t* KPE, bf16_t* mix, const float* tab, LAS unsigned char* lds, int tid) {
    const int lane = tid & 63, wave = __builtin_amdgcn_readfirstlane(tid >> 6);
    const bool dec = idx < 64; int b, hh, qb; if (dec) { b = idx >> 5; hh = (idx >> 2) & 7; qb = idx & 3; } else { const int i2 = idx - 64; b = i2 >> 3; hh = i2 & 7; qb = 0; }
    const int row0 = dec ? NCTX + b * 1024 + qb * 256 : b * 256, nkeys = dec ? 1280 : 256, krow0 = dec ? NCTX + b * 1280 : b * 256;
    f32x16 o[4]; float l;
    attn_wg<12, 8>(CQ + (size_t)row0 * 1536 + hh * 192, 1536, KV + (size_t)krow0 * 2048 + hh * 256, 2048, KPE + (size_t)krow0 * 64, 64, nkeys, KV + (size_t)krow0 * 2048 + hh * 256 + 128, 2048, C_MLA, o, l, lds, tid, dec ? tab : (const float*)nullptr, qb * 256);
    store_ot(o, 1.0f / l, mix + (size_t)(row0 + wave * 32) * DM + 1024 + hh * 128, DM, lane);
}
DI void opmix_row(const bf16_t* HF, const bf16_t* raw, int row, const float* g, bf16_t* mix, int lane) {
#pragma unroll
    for (int it = 0; it < 2; ++it) {
        const int c0 = (it * 64 + lane) * 8; const bf16_t* h0 = HF + (size_t)row * 1024 + c0; const bf16_t* h1 = h0 + (size_t)MTOK * 1024;
        const u32x4 w0 = *(const u32x4*)h0, w1 = *(const u32x4*)h1; float f[8], f1[8]; unpack8(w0, f); unpack8(w1, f1); float ss = 0.f;
#pragma unroll
        for (int e = 0; e < 8; ++e) f[e] += f1[e];
#pragma unroll
        for (int e = 0; e < 8; ++e) ss += f[e] * f[e];
        ss = grp16_sum(ss); const float rstd = frsq(ss * (1.0f / 128.0f) + EPS);
        const u32x4 ow = *(const u32x4*)(raw + (size_t)row * ODD_INP + 3072 + c0); float om[8]; unpack8(ow, om);
#pragma unroll
        for (int e = 0; e < 8; ++e) f[e] = f[e] * rstd * g[(c0 & 127) + e] * sigmoidf_(om[e]);
        *(u32x4*)(mix + (size_t)row * DM + c0) = pack8(f);
    }
}
#ifndef MK_PER_PHASE
#define MK_PER_PHASE 0
#endif
constexpr int NPHASE = 38;
#define AIN(i) ((const float*)(const GAS float*)ainq[i])
struct Args { const float* in[N_IN]; float* out; unsigned char* ws; int ph_lo, ph_hi; };
static_assert(sizeof(Args) == N_IN * 8 + 8 + 8 + 8, "Args has no padding");
constexpr int CW_BAR = 4096;
constexpr int I_EIN = 1152, I_OIN = 1280, I_OUT = 512, I_UP = 2816, I_DN = 1408, I_UQ = 96, I_UKV = 64;

typedef const __attribute__((address_space(4))) unsigned long long* kargp_t;
DI void wconv(kargp_t ainq, unsigned char* ws, int layer, int part, long t0, long nt, int lane, LAS unsigned char* lw) {
    const int jh = layer >> 1; const bool odd = (layer & 1) != 0;
    const int nin = odd ? I_OIN : I_EIN, total = part ? (I_UP + I_DN) : (nin + I_OUT + (odd ? I_UQ + I_UKV : 0));
    unsigned* ctr = (unsigned*)ws + 64 * (1 + layer * 2 + part);
    for (;;) {
        unsigned base = 0u; if (lane == 0) base = __hip_atomic_fetch_add(ctr, 4u, __ATOMIC_RELAXED, __HIP_MEMORY_SCOPE_AGENT);
        base = (unsigned)__builtin_amdgcn_readfirstlane((int)base);
        if ((int)base >= total) break;
#pragma unroll 1
        for (int kk = 0; kk < 4; ++kk) {
            const int it = (int)base + kk; if (it >= total) break;
            int r = it, K, N; const float* W; bf16_t* WT;
            if (part) {
                if (r < I_UP) { W = AIN(I_FUP) + (size_t)layer * 2048 * DFF2; WT = (bf16_t*)(ws + WS_WUP + (size_t)layer * WUP_STRIDE); K = 2048; N = DFF2; }
                else { r -= I_UP; W = AIN(I_FDN) + (size_t)layer * DFF * 2048; WT = (bf16_t*)(ws + WS_WDN + (size_t)layer * WDN_STRIDE); K = DFF; N = 2048; }
            } else {
                if (r < nin) { W = odd ? AIN(I_OWIN) + (size_t)jh * 2048 * ODD_IN : AIN(I_EWIN) + (size_t)jh * 2048 * EVEN_IN; WT = (bf16_t*)(ws + WS_WIN + (size_t)layer * WIN_STRIDE); K = 2048; N = odd ? ODD_IN : EVEN_IN; }
                else if ((r -= nin) < I_OUT) { W = (odd ? AIN(I_OWOUT) : AIN(I_EWOUT)) + (size_t)jh * 2048 * 2048; WT = (bf16_t*)(ws + WS_WOUT + (size_t)layer * WOUT_STRIDE); K = 2048; N = 2048; }
                else if ((r -= I_OUT) < I_UQ) { W = AIN(I_WUQ) + (size_t)jh * 512 * 1536; WT = (bf16_t*)(ws + WS_WUQ + (size_t)jh * WUQ_STRIDE); K = 512; N = 1536; }
                else { r -= I_UQ; W = AIN(I_WUKV) + (size_t)jh * 256 * 2048; WT = (bf16_t*)(ws + WS_WUKV + (size_t)jh * WUKV_STRIDE); K = 256; N = 2048; }
            }
            p0_tr64(W, K, N, WT, r, lane, (part && N == DFF2) ? 1 : (!part && N == ODD_IN) ? 2 : 0, lw);
        }
    }
    if (!part && odd) { unsigned zz_ = 0u; asm volatile("" : "+v"(zz_));
        for (long i = t0; i < 40960; i += nt) *(u32x4*)((bf16_t*)(ws + WS_WIN + (size_t)layer * WIN_STRIDE) + (size_t)ODD_IN * 2048 + i * 8) = (u32x4){zz_, zz_, zz_, zz_}; }
}

__global__ void __launch_bounds__(NTHR, 2) fwd_kernel(Args args) {
    extern __shared__ __attribute__((aligned(16))) unsigned char lds_raw[];
    LAS unsigned char* lds = (LAS unsigned char*)lds_raw;
    const int tid0 = threadIdx.x; const int wave0 = __builtin_amdgcn_readfirstlane(tid0 >> 6);
    const int bid0 = blockIdx.x, nb = gridDim.x, ngw = nb * NWAVES;
    const long ngt = (long)nb * NTHR;
    unsigned char* const ws0 = args.ws; float* const out0 = args.out;
    const int lo = args.ph_lo, hi = args.ph_hi; const bool multi = (hi - lo) > 1;
    for (int u = tid0; u < (LDS_BYTES - LDSCTL_OFF) / 4; u += NTHR) ((LAS unsigned*)(lds + LDSCTL_OFF))[u] = 0u;
    __syncthreads();
    XcdBarrier bar; bar.bar = (unsigned*)ws0 + CW_BAR; bar.x = 0; bar.st = nullptr;
    if (multi) bar = xcd_barrier_post((unsigned*)ws0 + CW_BAR, (volatile LAS unsigned*)(lds + MISC_OFF) + 8);
    int pid = 0; (void)pid; (void)lo;
#if MK_PER_PHASE
#define PH_COND (pid >= lo && pid < hi)
#define PH_END   if (pid + 1 < hi) xcd_barrier_fast(bar, tid); } ++pid;
#define PH_END_FIRST if (pid + 1 < hi) xcd_barrier(bar, tid); } ++pid;
#define PH_END_LAST } ++pid;
#else
#define PH_COND (true)
#define PH_END   xcd_barrier_fast(bar, tid); }
#define PH_END_FIRST xcd_barrier(bar, tid); }
#define PH_END_LAST }
#endif
#define PH_BEGIN if (PH_COND) { unsigned full_ = ~0u; asm volatile("" : "+s"(full_)); int tid = wave0 * 64 + (int)__builtin_amdgcn_mbcnt_hi(full_, __builtin_amdgcn_mbcnt_lo(full_, 0u)); asm volatile("" : "+v"(tid));     \
    int bid = bid0; asm volatile("" : "+s"(bid));     \
    const int lane = tid & 63, wave = __builtin_amdgcn_readfirstlane(tid >> 6), gw = bid * NWAVES + wave; \
    const long gtid = (long)bid * NTHR + tid; (void)lane; (void)gw; (void)gtid; (void)wave; \
    unsigned long long ws_u = (unsigned long long)ws0, out_u = (unsigned long long)out0; const __attribute__((address_space(4))) unsigned long long* ainq = (const __attribute__((address_space(4))) unsigned long long*)__builtin_amdgcn_kernarg_segment_ptr(); \
    asm volatile("" : "+s"(ws_u), "+s"(out_u), "+s"(ainq)); unsigned char* ws = (unsigned char*)(GAS unsigned char*)ws_u; float* out = (float*)(GAS float*)out_u; (void)out; (void)ainq; \
    float* modraw = (float*)(ws + WS_MODRAW); float* tab = (float*)(ws + WS_ROPE); bf16_t* X = (bf16_t*)(ws + WS_X); bf16_t* H = (bf16_t*)(ws + WS_H); bf16_t* RAW = (bf16_t*)(ws + WS_RAW); bf16_t* MIX = (bf16_t*)(ws + WS_MIX); \
    bf16_t* U = (bf16_t*)(ws + WS_U); bf16_t* ACT = (bf16_t*)(ws + WS_ACT); bf16_t* PART = (bf16_t*)(ws + WS_PART); (void)PART; (void)modraw; (void)tab; (void)X; (void)H; (void)RAW; (void)MIX; (void)U; (void)ACT;

    PH_BEGIN
    {
        LAS float* sc = (LAS float*)lds; LAS float* red = (LAS float*)(lds + 24576);
        for (int i = tid; i < 3 * 2048; i += NTHR) { const int v = i >> 11, k = i & 2047; const float x = (v == 0) ? AIN(I_CCTX)[k] : AIN(I_C)[(v - 1) * 2048 + k]; sc[i] = siluf_(x); }
        __syncthreads();
        const float* wmod = AIN(I_WMOD);
        for (int item = bid; item < 4 * 192; item += nb) {
            const int l = item / 192, cc = item % 192, n = cc * 64 + lane, k0 = wave * 256;
            const float* wp = wmod + ((size_t)l * 2048 + k0) * 12288 + n;
            float s0 = 0.f, s1 = 0.f, s2 = 0.f;
#pragma unroll 32
            for (int k = 0; k < 256; ++k) { const float w = wp[(size_t)k * 12288]; s0 += sc[k0 + k] * w; s1 += sc[2048 + k0 + k] * w; s2 += sc[4096 + k0 + k] * w; }
            red[(wave * 3 + 0) * 64 + lane] = s0; red[(wave * 3 + 1) * 64 + lane] = s1; red[(wave * 3 + 2) * 64 + lane] = s2;
            __syncthreads();
            if (tid < 192) { const int v = tid >> 6, ln = tid & 63; float s = AIN(I_BMOD)[(size_t)l * 12288 + cc * 64 + ln];
#pragma unroll
                for (int w = 0; w < 8; ++w) s += red[(w * 3 + v) * 64 + ln];
                modraw[(size_t)(l * 3 + v) * 12288 + cc * 64 + ln] = s; }
            __syncthreads();
        }
    }
    for (long i = gtid; i < 2048; i += ngt) rope_table_entry(tab, (int)i);
#pragma unroll 1
    for (int q = 0; q < 2; ++q) wconv(ainq, ws, 0, q, gtid, ngt, lane, lds + wave * 18432);
    PH_END_FIRST

    for (int l = 0; l < 4; ++l) {
        const int j = l >> 1; const bool odd = (l & 1) != 0;
        const int NIN = odd ? ODD_INP : EVEN_IN;
        PH_BEGIN
        { const void* xc = (l == 0) ? (const void*)AIN(I_XP) : (const void*)X; const void* xd = (l == 0) ? (const void*)AIN(I_XS) : (const void*)(X + (size_t)NCTX * DM);
          norm_mod_rows(xc, l == 0, xd, l == 0, AIN(I_N1G) + l * 2048, modraw + (size_t)l * 3 * 12288, 0, H, (l == 0) ? (const float*)nullptr : modraw + (size_t)(l - 1) * 3 * 12288 + 5 * 2048, PART, X, gw, ngw, lane); }
        PH_END
        PH_BEGIN
        { const int npw = odd ? 19 : 18;
          pg8::Gemm g{H, (const bf16_t*)(ws + WS_WIN + (size_t)l * WIN_STRIDE), MTOK, NIN, 2048, 2048}; InOrder S; S.S0.init(MTOK, npw * 256, nb, bid); S.G = nb; S.c = bid; S.nW = 40 * npw; S.nQ = odd ? 160 : 0;
          EpiInQ E{pg8::EpiBf16<0>{RAW, NIN, nullptr, 0, 0, 1.f}, (bf16_t*)(ws + WS_U + 4 * MiB), npw};
          pg8::gemm_phase<EpiInQ, InOrder, true, true>(lds, g, S, E, tid); }
        {
            const int first = (nb == 256) ? (odd ? 152 : 208) : 0, nidle = nb - first;
            if (bid >= first) for (int it = (bid - first) * NWAVES + wave; it < 512; it += nidle * NWAVES) {
                if (!odd) epost_cache(it, j, AIN(I_CDAK), AIN(I_CDAV), AIN(I_CGQK), AIN(I_CGQV), (bf16_t*)(ws + WE_KAD), (bf16_t*)(ws + WE_KBD), (bf16_t*)(ws + WE_VTA_D), (bf16_t*)(ws + WE_VTB_D), lane);
                else opost_cache(it, j, AIN(I_CCKV), AIN(I_CKPE), (bf16_t*)(ws + WO_CKV), (bf16_t*)(ws + WO_KPE), lane); } }
        PH_END
        if (!odd) {
            PH_BEGIN
            bf16_t* KAd = (bf16_t*)(ws + WE_KAD); bf16_t* KBd = (bf16_t*)(ws + WE_KBD); bf16_t* VAd = (bf16_t*)(ws + WE_VTA_D); bf16_t* VBd = (bf16_t*)(ws + WE_VTB_D);
            for (int it = gw; it < 10240; it += ngw) {
                if (it < 10240) epost_row(RAW, it, j, out, AIN(I_GQQN) + j * 128, AIN(I_GQKN) + j * 128, KAd, KBd, VAd, VBd, tab, lane);
            }
            PH_END
            PH_BEGIN
            bf16_t* KAd = (bf16_t*)(ws + WE_KAD); bf16_t* KBd = (bf16_t*)(ws + WE_KBD); bf16_t* VAd = (bf16_t*)(ws + WE_VTA_D); bf16_t* VBd = (bf16_t*)(ws + WE_VTB_D);
            { const float lam_init = j ? 0.4707130183435842f : 0.2f;
              const int nit = (nb == 256) ? 4 : (640 + nb - 1) / nb;
#pragma unroll 1
              for (int i = 0; i < nit; ++i) {
                int kind = -1, idx = 0;
                if (nb == 256) {
                    if (bid < 64) { if (i == 0) { kind = 0; idx = bid; } }
                    else if (bid < 128) { if (i == 0) { kind = 1; idx = bid - 64; } else if (i == 1) { kind = 1; idx = 64 + (bid - 64); } }
                    else { const int k = bid - 128; if (i == 0) { kind = 0; idx = 64 + k; } else if (i == 1) { kind = 0; idx = 64 + 128 + k; } else if (i == 2) { kind = 1; idx = 64 + 64 + k; } else if (k < 64) { kind = 1; idx = 64 + 192 + k; } }
                } else { const int u = bid + i * nb; if (u < 64) { kind = 0; idx = u; } else if (u < 128) { kind = 1; idx = u - 64; } else if (u < 384) { kind = 0; idx = 64 + (u - 128); } else if (u < 640) { kind = 1; idx = 64 + (u - 384); } }
                if (kind == 0) da_unit(idx, j, RAW, KAd, VAd, AIN(I_DALAM), AIN(I_DALN), lam_init, MIX, tab, lds, tid);
                else if (kind == 1) gqa_unit(idx, RAW, KBd, VBd, MIX, AIN(I_GQQN) + j * 128, tab, lds, tid);
              }
              __syncthreads();
              wconv(ainq, ws, l + 1 - (l >> 1), l >> 1, gtid, ngt, lane, lds + wave * 18432); }
            PH_END
        } else {
            PH_BEGIN
            bf16_t* QM = (bf16_t*)(ws + WO_QM); bf16_t* KM = (bf16_t*)(ws + WO_KM); float* G = (float*)(ws + WO_G); bf16_t* QD = (bf16_t*)(ws + WO_QD); bf16_t* CKV = (bf16_t*)(ws + WO_CKV); bf16_t* KPE = (bf16_t*)(ws + WO_KPE); bf16_t* CQ = (bf16_t*)(ws + WO_CQ); bf16_t* KV = (bf16_t*)(ws + WO_KV); bf16_t* HF = (bf16_t*)(ws + WO_HF);
            for (int it = gw; it < 10240 + 5120; it += ngw) {
                if (it < 10240) opost_row(RAW, (const bf16_t*)(ws + WS_U + 4 * MiB), it, j, out, AIN(I_MLGB), AIN(I_MLAQN), AIN(I_MLAKVN), G, QD, CKV, KPE, tab, lane);
                else opost_conv(RAW, it - 10240, j, AIN(I_MLCW), AIN(I_MLCB), QM, KM, lane);
            }
            PH_END
            PH_BEGIN
            bf16_t* QM = (bf16_t*)(ws + WO_QM); bf16_t* KM = (bf16_t*)(ws + WO_KM); float* G = (float*)(ws + WO_G); bf16_t* QD = (bf16_t*)(ws + WO_QD); bf16_t* CKV = (bf16_t*)(ws + WO_CKV); bf16_t* KPE = (bf16_t*)(ws + WO_KPE); bf16_t* CQ = (bf16_t*)(ws + WO_CQ); bf16_t* KV = (bf16_t*)(ws + WO_KV); bf16_t* HF = (bf16_t*)(ws + WO_HF);
            { pg8::Gemm g{QD, (const bf16_t*)(ws + WS_WUQ + (size_t)j * WUQ_STRIDE), MTOK, 1536, 512, 512}; pg8::StaticOrder S; S.init(MTOK, 1536, nb, bid);
              pg8::EpiBf16<0> E{CQ, 1536, nullptr, 0, 0, 1.f};
              pg8::gemm_phase<pg8::EpiBf16<0>, pg8::StaticOrder, true, true>(lds, g, S, E, tid); }
            { pg8::Gemm g{CKV, (const bf16_t*)(ws + WS_WUKV + (size_t)j * WUKV_STRIDE), MKV, 2048, 256, 256}; pg8::StaticOrder S; S.init(MKV, 2048, nb, bid);
              pg8::EpiBf16<0> E{KV, 2048, nullptr, 0, 0, 1.f};
              pg8::gemm_phase<pg8::EpiBf16<0>, pg8::StaticOrder, true, true>(lds, g, S, E, tid); }
            PH_END
            PH_BEGIN
            bf16_t* QM = (bf16_t*)(ws + WO_QM); bf16_t* KM = (bf16_t*)(ws + WO_KM); float* G = (float*)(ws + WO_G); bf16_t* QD = (bf16_t*)(ws + WO_QD); bf16_t* CKV = (bf16_t*)(ws + WO_CKV); bf16_t* KPE = (bf16_t*)(ws + WO_KPE); bf16_t* CQ = (bf16_t*)(ws + WO_CQ); bf16_t* KV = (bf16_t*)(ws + WO_KV); bf16_t* HF = (bf16_t*)(ws + WO_HF);
            { LAS float* scb = (LAS float*)(lds + LDSCTL_OFF + 1024);
              const int nml = (nb == 256) ? 2 : (32 + 256 + nb - 1) / nb;
#pragma unroll 1
              for (int i = 0; i < nml; ++i) {
                int u = -1, ds = -1;
                if (nb == 256) { if (bid < 32) { if (i == 0) { u = bid >> 1; ds = bid & 1; } } else { const int k = bid - 32; if (i == 0) u = 16 + k; else if (k < 32) u = 16 + 224 + k; } }
                else { const int uu = bid + i * nb; if (uu < 32) { u = uu >> 1; ds = uu & 1; } else if (uu < 288) u = 16 + (uu - 32); }
                if (u >= 0) mlstm_wg(u, ds, j, QM, KM, RAW, G, AIN(I_SC), AIN(I_SN), AIN(I_SM), HF, out, AIN(I_MLNG) + j * 128, MIX, lds, scb, tid);
              }
              const int nit = (nb == 256) ? 2 : (320 + nb - 1) / nb;
#pragma unroll 1
              for (int i = 0; i < nit; ++i) {
                int idx = -1;
                if (nb == 256) { if (bid >= 64 && bid < 128) { if (i == 0) idx = bid - 64; } else if (bid >= 128) { const int k = bid - 128; if (i == 0) idx = 64 + k; else idx = 64 + 128 + k; } }
                else { const int u = bid + i * nb; if (u < 320) idx = u; }
                if (idx >= 0) mla_unit(idx, CQ, KV, KPE, MIX, tab, lds, tid);
              }
              { const int nq = (l == 1) ? 3 : 1;
#pragma unroll 1
                for (int q = 0; q < nq; ++q) { const int cl = (l == 1) ? 1 + q : 3, cp = (l == 1) ? (q == 0 ? 1 : 0) : 1; wconv(ainq, ws, cl, cp, gtid, ngt, lane, lds + wave * 18432); } } }
            PH_END
            PH_BEGIN
            bf16_t* QM = (bf16_t*)(ws + WO_QM); bf16_t* KM = (bf16_t*)(ws + WO_KM); float* G = (float*)(ws + WO_G); bf16_t* QD = (bf16_t*)(ws + WO_QD); bf16_t* CKV = (bf16_t*)(ws + WO_CKV); bf16_t* KPE = (bf16_t*)(ws + WO_KPE); bf16_t* CQ = (bf16_t*)(ws + WO_CQ); bf16_t* KV = (bf16_t*)(ws + WO_KV); bf16_t* HF = (bf16_t*)(ws + WO_HF);
            for (int row = NCTX + gw; row < MTOK; row += ngw) opmix_row(HF, RAW, row, AIN(I_MLNG) + j * 128, MIX, lane);
            PH_END
        }
        PH_BEGIN
        {
          const void* xc = (l == 0) ? (const void*)AIN(I_XP) : (const void*)X;
          pg8::Gemm g{MIX, (const bf16_t*)(ws + WS_WOUT + (size_t)l * WOUT_STRIDE), MTOK, 2048, 2048, 2048}; OutOrder S; S.G = nb; S.c = bid; S.Kq = 512;
          EpiResPart E{EpiResid{xc, l == 0, X, modraw + (size_t)l * 3 * 12288 + 2 * 2048}, EpiPart{PART - (size_t)NCTX * DM}};
          pg8::gemm_phase<EpiResPart, OutOrder, true, true>(lds, g, S, E, tid); }
        PH_END
        PH_BEGIN
        norm_mod_rows(X, 0, (l == 0) ? (const void*)AIN(I_XS) : (const void*)(X + (size_t)NCTX * DM), l == 0, AIN(I_N2G) + l * 2048, modraw + (size_t)l * 3 * 12288, 3, H, modraw + (size_t)l * 3 * 12288 + 2 * 2048, PART, X, gw, ngw, lane);
        PH_END
        PH_BEGIN
        { pg8::Gemm g{H, (const bf16_t*)(ws + WS_WUP + (size_t)l * WUP_STRIDE), MTOK, DFF2, 2048, 2048}; pg8::StaticOrder S; S.init(MTOK, DFF2, nb, bid);
          EpiUp E{(float*)U, ACT, AIN(I_FCW) + (size_t)l * 3 * DFF2, AIN(I_FCB) + (size_t)l * DFF2, (LAS float*)(lds + 131072)};
          pg8::gemm_phase<EpiUp, pg8::StaticOrder, true, true>(lds, g, S, E, tid); }
        PH_END
        PH_BEGIN
        { pg8::Gemm g{ACT, (const bf16_t*)(ws + WS_WDN + (size_t)l * WDN_STRIDE), MTOK, 2048, DFF, DFF}; OutOrder S; S.G = nb; S.c = bid; S.Kq = DFF / 4;
          for (int i = 0; i * nb < 512; ++i) { const int L = S.latent_of(i); if (L >= 0) ffn_edge_fix(L, (const float*)U, AIN(I_FCW) + (size_t)l * 3 * DFF2, AIN(I_FCB) + (size_t)l * DFF2, ACT, tid); }
          asm volatile("s_waitcnt vmcnt(0)" ::: "memory"); __syncthreads();
          EpiResPart E{EpiResid{X, 0, X, modraw + (size_t)l * 3 * 12288 + 5 * 2048}, EpiPart{PART - (size_t)NCTX * DM}};
          pg8::gemm_phase<EpiResPart, OutOrder, true, true>(lds, g, S, E, tid); }
        PH_END
    }
    PH_BEGIN
    final_norm_rows(X, AIN(I_FNG), out, modraw + (size_t)3 * 3 * 12288 + 5 * 2048, PART, gw, ngw, lane);
    PH_END_LAST
#undef PH_BEGIN
#undef PH_END
#undef PH_END_LAST
#undef PH_END_FIRST
#undef PH_COND
}

extern "C" void kernel_launch(void* const* d_in, const int* in_sizes, int n_in, void* d_out, int out_size, void* d_ws, size_t ws_size, hipStream_t stream) {
    static int grid = 0;
    if (grid == 0) {
        if (n_in != N_IN || (size_t)out_size != O_END || ws_size < WS_END) { fprintf(stderr, "kernel_launch: unexpected shapes: n_in %d out %d ws %zu (need %zu)\n", n_in, out_size, ws_size, (size_t)WS_END); grid = -1; return; }
        int dev = 0, cus = 0, per_cu = 0;
        if (hipGetDevice(&dev) != hipSuccess || hipDeviceGetAttribute(&cus, hipDeviceAttributeMultiprocessorCount, dev) != hipSuccess) { grid = -1; return; }
        if (hipFuncSetAttribute((const void*)fwd_kernel, hipFuncAttributeMaxDynamicSharedMemorySize, LDS_BYTES) != hipSuccess) { fprintf(stderr, "kernel_launch: hipFuncSetAttribute failed\n"); grid = -1; return; }
        if (hipOccupancyMaxActiveBlocksPerMultiprocessor(&per_cu, (const void*)fwd_kernel, NTHR, LDS_BYTES) != hipSuccess || per_cu < 1) fprintf(stderr, "kernel_launch: occupancy query says %d\n", per_cu);
        (void)hipGetLastError();
        grid = cus;
    }
    if (grid < 0) return;
    if (hipMemsetAsync((char*)d_ws + WS_CTL, 0, CTL_ZERO_BYTES, stream) != hipSuccess) { fprintf(stderr, "kernel_launch: memset failed\n"); return; }
    Args a{};
    for (int i = 0; i < N_IN; ++i) a.in[i] = (const float*)d_in[i];
    a.out = (float*)d_out; a.ws = (unsigned char*)d_ws;
#if MK_PER_PHASE
    for (int p = 0; p < NPHASE; ++p) { a.ph_lo = p; a.ph_hi = p + 1; hipLaunchKernelGGL(fwd_kernel, dim3(grid), dim3(NTHR), LDS_BYTES, stream, a); }
#else
    a.ph_lo = 0; a.ph_hi = NPHASE; hipLaunchKernelGGL(fwd_kernel, dim3(grid), dim3(NTHR), LDS_BYTES, stream, a);
#endif
    const hipError_t le = hipPeekAtLastError();
    if (le != hipSuccess) fprintf(stderr, "kernel_launch: launch failed: %s\n", hipGetErrorName(le));
}
```
